# Optimizing an MI355X kernel written in HIP

```python
import jax
import jax.numpy as jnp
from jax import lax
import numpy as np

D_MODEL = 1024
BATCH = 8
SEQ = 2048
DEPTH = 4
DEC_BATCH = 2
DEC_SEQ = 8192
PAST_LEN = 128

MEM_LEN = 256
GRID_W = 64
HEAD_DIM = 64
Q_BLOCK = 128
ROPE_THETA = 10000.0
EPS = 1e-6
MLA_HEADS = 6
MLA_Q_RANK = 256
MLA_KV_RANK = 128
MLA_NOPE = 64
MLA_ROPE = 32
MLA_V = 64
MLA_QK = MLA_NOPE + MLA_ROPE
NA_HEADS = 6
NA_WIN_R = 8
NA_WIN_C = 16
DIL_WINDOWS = (128, 512, 2048)
DIL_RATES = (1, 4, 16)
DIL_GROUPS = 3
DIL_HEADS = 4
DIL_ALL = DIL_GROUPS * DIL_HEADS
X_HEADS = 4
X_HEAD_DIM = D_MODEL // X_HEADS
D_FF = 2816
CONV_W = 3
SPLIT_CQ = MLA_Q_RANK
SPLIT_CKV = SPLIT_CQ + MLA_KV_RANK
SPLIT_KR = SPLIT_CKV + MLA_ROPE
SPLIT_NA = SPLIT_KR + 3 * NA_HEADS * HEAD_DIM
D_IN = SPLIT_NA + 3 * DIL_ALL * HEAD_DIM
MIX_OUT = MLA_HEADS * MLA_V + NA_HEADS * HEAD_DIM + DIL_HEADS * HEAD_DIM

kernel_name = 'hybrid_mla_natten_dilated_encoder'


def rmsnorm(x, g):
    xf = x.astype(jnp.float32)
    y = xf * lax.rsqrt(jnp.mean(xf * xf, axis=-1, keepdims=True) + EPS)
    return (y * g.astype(jnp.float32)).astype(x.dtype)


def rope(x, pos):
    half = x.shape[-1] // 2
    inv = ROPE_THETA ** (-jnp.arange(half, dtype=jnp.float32) / half)
    ang = pos.astype(jnp.float32)[:, None] * inv[None, :]
    cos = jnp.cos(ang)[:, None, :].astype(x.dtype)
    sin = jnp.sin(ang)[:, None, :].astype(x.dtype)
    x1, x2 = x[..., :half], x[..., half:]
    return jnp.concatenate([x1 * cos - x2 * sin, x2 * cos + x1 * sin], axis=-1)


def block_dense_attention(q, k, v):
    B, S, H, dk = q.shape
    nb = S // Q_BLOCK
    scale = dk ** -0.5
    qb = q.reshape(B, nb, Q_BLOCK, H, dk).transpose(1, 0, 2, 3, 4)

    def one(qblk):
        s = jnp.einsum('bqhd,bkhd->bhqk', qblk, k).astype(jnp.float32) * scale
        p = jax.nn.softmax(s, axis=-1).astype(v.dtype)
        return jnp.einsum('bhqk,bkhd->bqhd', p, v)

    o = lax.map(one, qb)
    return o.transpose(1, 0, 2, 3, 4).reshape(B, S, H, v.shape[-1])


def mla_attention(c_q, c_kv, k_r, lp, pos):
    B, S, _ = c_q.shape
    c_q = rmsnorm(c_q, lp['mla_q_norm'])
    c_kv = rmsnorm(c_kv, lp['mla_kv_norm'])
    q = (c_q @ lp['w_uq']).reshape(B, S, MLA_HEADS, MLA_QK)
    k_nope = (c_kv @ lp['w_uk']).reshape(B, S, MLA_HEADS, MLA_NOPE)
    v = (c_kv @ lp['w_uv']).reshape(B, S, MLA_HEADS, MLA_V)
    k = jnp.concatenate([k_nope, jnp.broadcast_to(k_r[:, :, None, :], (B, S, MLA_HEADS, MLA_ROPE))], axis=-1)
    q = rmsnorm(q, lp['mla_qn'])
    k = rmsnorm(k, lp['mla_kn'])
    q = jnp.concatenate([q[..., :MLA_NOPE], rope(q[..., MLA_NOPE:], pos)], axis=-1)
    k = jnp.concatenate([k[..., :MLA_NOPE], rope(k[..., MLA_NOPE:], pos)], axis=-1)
    return block_dense_attention(q, k, v)


def neighbourhood_attention(q, k, v, rpb):
    B, S, H, d = q.shape
    rows = S // GRID_W
    kr_ = min(NA_WIN_R, rows)
    kc = NA_WIN_C
    qg = q.reshape(B, rows, GRID_W, H, d).transpose(1, 0, 2, 3, 4)
    kg = k.reshape(B, rows, GRID_W, H, d)
    vg = v.reshape(B, rows, GRID_W, H, d)
    r_idx = jnp.arange(rows)
    r_start = jnp.clip(r_idx - kr_ // 2, 0, rows - kr_)
    c_idx = np.arange(GRID_W)
    c_start = np.clip(c_idx - kc // 2, 0, GRID_W - kc)
    c_keys = c_start[:, None] + np.arange(kc)[None, :]
    c_off = c_keys - c_idx[:, None] + (NA_WIN_C - 1)
    bias_c = rpb[:, :, c_off]
    scale = d ** -0.5

    def one(args):
        q_row, r, rs = args
        k_rows = lax.dynamic_slice_in_dim(kg, rs, kr_, axis=1)
        v_rows = lax.dynamic_slice_in_dim(vg, rs, kr_, axis=1)
        k_nb = k_rows[:, :, c_keys]
        v_nb = v_rows[:, :, c_keys]
        s = jnp.einsum('bqhd,brqjhd->bhqrj', q_row, k_nb).astype(jnp.float32) * scale
        r_off = rs + jnp.arange(kr_) - r + (NA_WIN_R - 1)
        bias = jnp.take(bias_c, r_off, axis=1).transpose(0, 2, 1, 3)
        s = s + bias[None].astype(jnp.float32)
        p = jax.nn.softmax(s.reshape(B, H, GRID_W, kr_ * kc), axis=-1).reshape(s.shape).astype(v.dtype)
        return jnp.einsum('bhqrj,brqjhd->bqhd', p, v_nb)

    o = lax.map(one, (qg, r_idx, r_start))
    return o.transpose(1, 0, 2, 3, 4).reshape(B, S, H * d)


def dilated_attention(q, k, v):
    B, S, _, d = q.shape
    G, Hg = DIL_GROUPS, DIL_HEADS
    offs = jnp.asarray(np.stack([r * np.arange(-(w // (2 * r)), w // (2 * r) + 1)
                                 for w, r in zip(DIL_WINDOWS, DIL_RATES)]))
    nb = S // Q_BLOCK
    qb = q.reshape(B, nb, Q_BLOCK, G, Hg, d).transpose(1, 0, 2, 3, 4, 5)
    kG = k.reshape(B, S, G, Hg, d).transpose(2, 0, 1, 3, 4)
    vG = v.reshape(B, S, G, Hg, d).transpose(2, 0, 1, 3, 4)
    scale = d ** -0.5

    def one(args):
        qblk, b0 = args
        pos = b0 + jnp.arange(Q_BLOCK)
        idx = pos[None, :, None] + offs[:, None, :]
        valid = (idx >= 0) & (idx < S)
        idx = jnp.clip(idx, 0, S - 1)
        kn = jax.vmap(lambda t, i: jnp.take(t, i, axis=1))(kG, idx)
        vn = jax.vmap(lambda t, i: jnp.take(t, i, axis=1))(vG, idx)
        s = jnp.einsum('bqghd,gbqjhd->gbhqj', qblk, kn).astype(jnp.float32) * scale
        s = jnp.where(valid[:, None, None], s, -jnp.inf)
        lse = jax.nn.logsumexp(s, axis=-1, keepdims=True)
        p = jnp.exp(s - lse).astype(v.dtype)
        o = jnp.einsum('gbhqj,gbqjhd->gbhqd', p, vn)
        alpha = jax.nn.softmax(lse[..., 0], axis=0).astype(v.dtype)
        return jnp.einsum('gbhq,gbhqd->bqhd', alpha, o)

    o = lax.map(one, (qb, jnp.arange(nb) * Q_BLOCK))
    return o.transpose(1, 0, 2, 3, 4).reshape(B, S, Hg * d)


def token_mixer(h, lp, pos):
    B, S, _ = h.shape
    z = h @ lp['w_in']
    c_q = z[..., :SPLIT_CQ]
    c_kv = z[..., SPLIT_CQ:SPLIT_CKV]
    k_r = z[..., SPLIT_CKV:SPLIT_KR]
    na = z[..., SPLIT_KR:SPLIT_NA].reshape(B, S, 3, NA_HEADS, HEAD_DIM)
    dl = z[..., SPLIT_NA:].reshape(B, S, 3, DIL_ALL, HEAD_DIM)
    o_a = mla_attention(c_q, c_kv, k_r, lp, pos).reshape(B, S, MLA_HEADS * MLA_V)
    q_b = rmsnorm(na[:, :, 0], lp['na_qn'])
    k_b = rmsnorm(na[:, :, 1], lp['na_kn'])
    o_b = neighbourhood_attention(q_b, k_b, na[:, :, 2], lp['na_rpb'])
    q_c = rope(rmsnorm(dl[:, :, 0], lp['dil_qn']), pos)
    k_c = rope(rmsnorm(dl[:, :, 1], lp['dil_kn']), pos)
    o_c = dilated_attention(q_c, k_c, dl[:, :, 2])
    return jnp.concatenate([o_a, o_b, o_c], axis=-1) @ lp['w_o']


def memory_cross_attention(h, mem, lp):
    B, S, _ = h.shape
    M = mem.shape[1]
    q = (h @ lp['w_cq']).reshape(B, S, X_HEADS, X_HEAD_DIM)
    kv = (rmsnorm(mem, lp['norm_mem']) @ lp['w_ckv']).reshape(B, M, 2, X_HEADS, X_HEAD_DIM)
    q = rmsnorm(q, lp['x_qn'])
    k = rmsnorm(kv[:, :, 0], lp['x_kn'])
    v = kv[:, :, 1]
    s = jnp.einsum('bqhd,bkhd->bhqk', q, k).astype(jnp.float32) * (X_HEAD_DIM ** -0.5)
    p = jax.nn.softmax(s, axis=-1).astype(v.dtype)
    o = jnp.einsum('bhqk,bkhd->bqhd', p, v).reshape(B, S, D_MODEL)
    return o @ lp['w_co']


def conv_ffn(h, lp):
    S = h.shape[1]
    u = h @ lp['w_up']
    pad = CONV_W // 2
    up = jnp.pad(u, ((0, 0), (pad, pad), (0, 0)))
    w = lp['conv_w']
    u = sum(up[:, j:j + S] * w[j] for j in range(CONV_W)) + lp['conv_b']
    a, g = u[..., :D_FF], u[..., D_FF:]
    return (jax.nn.silu(g) * a) @ lp['w_down']


def encoder_trunk(x, mem, layers):
    S = x.shape[1]
    pos = jnp.arange(S)
    for l in range(DEPTH):
        lp = layers[l]
        x = x + token_mixer(rmsnorm(x, lp['norm_mix']), lp, pos)
        x = x + memory_cross_attention(rmsnorm(x, lp['norm_cross']), mem, lp)
        x = x + conv_ffn(rmsnorm(x, lp['norm_ffn']), lp)
    return x


def setup_inputs(seed: int = 0) -> dict:
    key = jax.random.key(seed)
    ks = jax.random.split(key, 32)
    f32 = jnp.float32
    L = DEPTH
    res = (3 * DEPTH) ** -0.5

    def nrm(k, shape, scale):
        return jax.random.normal(k, shape, f32) * scale

    def gain(k, n):
        return 1.0 + 0.02 * jax.random.normal(k, (L, n), f32)

    return {
        'x_prompt': nrm(ks[0], (BATCH, SEQ, D_MODEL), 1.0),
        'x_sample': nrm(ks[1], (DEC_BATCH, DEC_SEQ, D_MODEL), 1.0),
        'mem_prompt': nrm(ks[2], (BATCH, MEM_LEN, D_MODEL), 1.0),
        'mem_sample': nrm(ks[3], (DEC_BATCH, MEM_LEN, D_MODEL), 1.0),
        'norm_mix': gain(ks[4], D_MODEL),
        'w_in': nrm(ks[5], (L, D_MODEL, D_IN), D_MODEL ** -0.5),
        'mla_q_norm': gain(ks[6], MLA_Q_RANK),
        'mla_kv_norm': gain(ks[7], MLA_KV_RANK),
        'w_uq': nrm(ks[8], (L, MLA_Q_RANK, MLA_HEADS * MLA_QK), MLA_Q_RANK ** -0.5),
        'w_uk': nrm(ks[9], (L, MLA_KV_RANK, MLA_HEADS * MLA_NOPE), MLA_KV_RANK ** -0.5),
        'w_uv': nrm(ks[10], (L, MLA_KV_RANK, MLA_HEADS * MLA_V), MLA_KV_RANK ** -0.5),
        'mla_qn': gain(ks[11], MLA_QK),
        'mla_kn': gain(ks[12], MLA_QK),
        'na_qn': gain(ks[13], HEAD_DIM),
        'na_kn': gain(ks[14], HEAD_DIM),
        'na_rpb': nrm(ks[15], (L, NA_HEADS, 2 * NA_WIN_R - 1, 2 * NA_WIN_C - 1), 0.1),
        'dil_qn': gain(ks[16], HEAD_DIM),
        'dil_kn': gain(ks[17], HEAD_DIM),
        'w_o': nrm(ks[18], (L, MIX_OUT, D_MODEL), MIX_OUT ** -0.5 * res),
        'norm_cross': gain(ks[19], D_MODEL),
        'norm_mem': gain(ks[20], D_MODEL),
        'w_cq': nrm(ks[21], (L, D_MODEL, D_MODEL), D_MODEL ** -0.5),
        'w_ckv': nrm(ks[22], (L, D_MODEL, 2 * D_MODEL), D_MODEL ** -0.5),
        'x_qn': gain(ks[23], X_HEAD_DIM),
        'x_kn': gain(ks[24], X_HEAD_DIM),
        'w_co': nrm(ks[25], (L, D_MODEL, D_MODEL), D_MODEL ** -0.5 * res),
        'norm_ffn': gain(ks[26], D_MODEL),
        'w_up': nrm(ks[27], (L, D_MODEL, 2 * D_FF), D_MODEL ** -0.5),
        'conv_w': nrm(ks[28], (L, CONV_W, 2 * D_FF), CONV_W ** -0.5),
        'conv_b': nrm(ks[29], (L, 2 * D_FF), 0.01),
        'w_down': nrm(ks[30], (L, D_FF, D_MODEL), D_FF ** -0.5 * res),
    }


def reference(x_prompt, x_sample, mem_prompt, mem_sample, norm_mix, w_in, mla_q_norm, mla_kv_norm,
              w_uq, w_uk, w_uv, mla_qn, mla_kn, na_qn, na_kn, na_rpb, dil_qn, dil_kn, w_o,
              norm_cross, norm_mem, w_cq, w_ckv, x_qn, x_kn, w_co, norm_ffn, w_up, conv_w, conv_b, w_down):
    layers = []
    for l in range(DEPTH):
        layers.append({
            'norm_mix': norm_mix[l], 'w_in': w_in[l], 'mla_q_norm': mla_q_norm[l],
            'mla_kv_norm': mla_kv_norm[l], 'w_uq': w_uq[l], 'w_uk': w_uk[l], 'w_uv': w_uv[l],
            'mla_qn': mla_qn[l], 'mla_kn': mla_kn[l], 'na_qn': na_qn[l], 'na_kn': na_kn[l],
            'na_rpb': na_rpb[l], 'dil_qn': dil_qn[l], 'dil_kn': dil_kn[l], 'w_o': w_o[l],
            'norm_cross': norm_cross[l], 'norm_mem': norm_mem[l], 'w_cq': w_cq[l], 'w_ckv': w_ckv[l],
            'x_qn': x_qn[l], 'x_kn': x_kn[l], 'w_co': w_co[l], 'norm_ffn': norm_ffn[l],
            'w_up': w_up[l], 'conv_w': conv_w[l], 'conv_b': conv_b[l], 'w_down': w_down[l],
        })
    y_prompt = encoder_trunk(x_prompt, mem_prompt, layers)
    y_sample = encoder_trunk(x_sample, mem_sample, layers)
    return (y_prompt, y_sample)
```

```cpp
#include <hip/hip_runtime.h>
#include <hip/hip_cooperative_groups.h>
#include <cstdio>
#include <cmath>
#include <cstring>
namespace cg = cooperative_groups;

typedef unsigned short bf16_t;
typedef short bf16x8 __attribute__((ext_vector_type(8)));
typedef short s16x4 __attribute__((ext_vector_type(4)));
typedef float f32x16 __attribute__((ext_vector_type(16)));
typedef float f32x4 __attribute__((ext_vector_type(4)));
typedef float f32x2 __attribute__((ext_vector_type(2)));
typedef unsigned u32x4 __attribute__((ext_vector_type(4)));
typedef unsigned u32x2 __attribute__((ext_vector_type(2)));

#define MFMA32(a, b, c) __builtin_amdgcn_mfma_f32_32x32x16_bf16((a), (b), (c), 0, 0, 0)

constexpr int T = 32768;
constexpr int NPR = 16384;
constexpr float EPS = 1e-6f;
constexpr float LOG2E = 1.4426950408889634f;
constexpr int LDS_BYTES = 68096;
constexpr int LDS_SSB = 66560;
constexpr int LDS_SSX = 67072;

constexpr size_t SZ_WT_IN = (size_t)3968 * 1024 * 2, SZ_WT_UQ = (size_t)768 * 256 * 2, SZ_WT_UKV = (size_t)768 * 128 * 2,
                 SZ_WT_SQ = (size_t)1024 * 1024 * 2, SZ_WT_UP = (size_t)5632 * 1024 * 2, SZ_WT_DOWN = (size_t)1024 * 2816 * 2,
                 SZ_WT_CKV = (size_t)2048 * 1024 * 2;
constexpr size_t OFF_WT_IN = 0, OFF_WT_UQ = OFF_WT_IN + SZ_WT_IN, OFF_WT_UKV = OFF_WT_UQ + SZ_WT_UQ, OFF_WT_O = OFF_WT_UKV + SZ_WT_UKV,
                 OFF_WT_CQ = OFF_WT_O + SZ_WT_SQ, OFF_WT_CO = OFF_WT_CQ + SZ_WT_SQ, OFF_WT_UP = OFF_WT_CO + SZ_WT_SQ,
                 OFF_WT_DOWN = OFF_WT_UP + SZ_WT_UP, OFF_WT_CKV = OFF_WT_DOWN + SZ_WT_DOWN;
constexpr size_t OFF_MEMK = OFF_WT_CKV + SZ_WT_CKV;
constexpr size_t OFF_MEMVT = OFF_MEMK + (size_t)2560 * 1024 * 2;
constexpr size_t OFF_MEMSS = OFF_MEMVT + (size_t)2560 * 1024 * 2;
constexpr size_t OFF_ROPE32 = OFF_MEMSS + (size_t)2560 * 16 * 4;
constexpr size_t OFF_ROPE16 = OFF_ROPE32 + (size_t)8192 * 32 * 8;
constexpr size_t OFF_LSE = OFF_ROPE16 + (size_t)8192 * 16 * 8;
constexpr size_t OFF_MQ = OFF_LSE + (size_t)T * 12 * 4;
constexpr size_t OFF_MK = OFF_MQ + (size_t)T * 576 * 2;
constexpr size_t OFF_MVT = OFF_MK + (size_t)T * 576 * 2;
constexpr size_t OFF_Z = OFF_MVT + (size_t)384 * T * 2;
constexpr size_t OFF_ZC = OFF_Z;
constexpr size_t OFF_NAQ = OFF_ZC + (size_t)T * 416 * 2;
constexpr size_t OFF_NAK = OFF_NAQ + (size_t)T * 384 * 2;
constexpr size_t OFF_NAVT = OFF_NAK + (size_t)T * 384 * 2;
constexpr size_t OFF_DQ = OFF_NAVT + (size_t)T * 384 * 2;
constexpr size_t OFF_DK = OFF_DQ + (size_t)T * 768 * 2;
constexpr size_t OFF_DVT = OFF_DK + (size_t)T * 768 * 2;
constexpr size_t WS_NEED = OFF_DVT + (size_t)T * 768 * 2;
constexpr size_t OFF_XQ = OFF_Z;
constexpr size_t OFF_XO = OFF_XQ + (size_t)T * 1024 * 2;
constexpr size_t OFF_ACT = OFF_Z;

struct P {
    const float *xp, *xs, *memp, *mems;
    const float *norm_mix, *w_in, *mla_q_norm, *mla_kv_norm, *w_uq, *w_uk, *w_uv, *mla_qn, *mla_kn, *na_qn, *na_kn, *na_rpb, *dil_qn,
        *dil_kn, *w_o, *norm_cross, *norm_mem, *w_cq, *w_ckv, *x_qn, *x_kn, *w_co, *norm_ffn, *w_up, *conv_w, *conv_b, *w_down;
    float* out;
    char* ws;
    float inv32[32];
    float inv16[16];
};

__device__ __forceinline__ unsigned pk2(float lo, float hi) { unsigned r; asm("v_cvt_pk_bf16_f32 %0, %1, %2" : "=v"(r) : "v"(lo), "v"(hi)); return r; }
__device__ __forceinline__ float bflo(unsigned u) { return __uint_as_float(u << 16); }
__device__ __forceinline__ float bfhi(unsigned u) { return __uint_as_float(u & 0xffff0000u); }
__device__ __forceinline__ bf16_t f2bf(float f) { return (bf16_t)(pk2(f, f) & 0xffffu); }
__device__ __forceinline__ int crow(int r, int hh) { return (r & 3) + 8 * (r >> 2) + 4 * hh; }
__device__ __forceinline__ void tokinfo(int t, int& sbase, int& S) {
    if (t < NPR) { S = 2048; sbase = t & ~2047; } else { S = 8192; sbase = NPR + ((t - NPR) & ~8191); }
}
__device__ __forceinline__ int permtok(int t, int g) {
    int sbase, S; tokinfo(t, sbase, S); const int sh = 2 * g, pos = t - sbase;
    return sbase + (pos & ((1 << sh) - 1)) * (S >> sh) + (pos >> sh);
}

__device__ __forceinline__ bool swz(int it, int MT, int NT, int& mt, int& nt) {
    const int x = it & 7, j = it >> 3;
    const int m_lo = (MT * x) >> 3, m_hi = (MT * (x + 1)) >> 3, mc = m_hi - m_lo;
    if (j >= mc * NT) return false;
    const int grp = j / (8 * NT), rem = j - grp * 8 * NT;
    int gsz = mc - grp * 8; gsz = gsz > 8 ? 8 : gsz;
    nt = rem / gsz; mt = m_lo + grp * 8 + (rem - nt * gsz); return true;
}
__host__ __device__ constexpr int swz_count(int MT, int NT) { return 8 * ((MT + 7) / 8) * NT; }

struct CvtJob { const float* src; bf16_t* dst; const float* gain; int K, N, mode; };
__device__ __forceinline__ int rowmap(int mode, int n) {
    if (mode == 1) return n < 416 ? n : n + 96;
    if (mode == 2) return (n / 96) * 128 + (n % 96);
    if (mode == 3) { const int g = n >= 2816, f = g ? n - 2816 : n; return (f >> 6) * 128 + g * 64 + (f & 63); }
    return n;
}
__device__ __forceinline__ void cvt_tile(const CvtJob& j, int tile, char* lds) {
    const int tid = threadIdx.x, ntn = (j.N + 63) >> 6, tk = tile / ntn, tn = tile - tk * ntn, k0 = tk * 64, n0 = tn * 64;
    float* tl = (float*)lds;
    { const int tx = tid & 63, ty = tid >> 6, n = n0 + tx;
#pragma unroll
      for (int i = 0; i < 16; ++i) { const int k = k0 + ty * 16 + i; float v = (n < j.N) ? j.src[(size_t)k * j.N + n] : 0.f; if (j.gain) v *= j.gain[k]; tl[tx * 65 + ty * 16 + i] = v; } }
    __syncthreads();
    { const int rn = tid >> 2, c = tid & 3, n = n0 + rn;
      if (n < j.N) { const float* s = tl + rn * 65 + c * 16; bf16_t* d = j.dst + (size_t)rowmap(j.mode, n) * j.K + k0 + c * 16;
        u32x4 a = {pk2(s[0], s[1]), pk2(s[2], s[3]), pk2(s[4], s[5]), pk2(s[6], s[7])}, b = {pk2(s[8], s[9]), pk2(s[10], s[11]), pk2(s[12], s[13]), pk2(s[14], s[15])};
        *(u32x4*)d = a; *(u32x4*)(d + 8) = b; } }
    __syncthreads();
}
enum { W_IN = 0, W_UQ, W_UK, W_UV, W_O, W_CQ, W_CO, W_UP, W_DOWN, W_CKV, W_NUM };
__host__ __device__ constexpr int cvt_tiles(int w) {
    return w == W_IN ? 16 * 61 : w == W_UQ ? 4 * 9 : (w == W_UK || w == W_UV) ? 2 * 6 : (w == W_O || w == W_CQ || w == W_CO) ? 256 : w == W_UP ? 16 * 88 : w == W_DOWN ? 44 * 16 : 16 * 32;
}
__host__ __device__ constexpr int cvt_count(unsigned mask) { int n = 0; for (int w = 0; w < W_NUM; ++w) if (mask & (1u << w)) n += cvt_tiles(w); return n; }
__device__ __forceinline__ CvtJob get_cvt(const P& p, int l, int w) {
    CvtJob j; j.gain = nullptr; j.mode = 0;
    switch (w) {
    case W_IN: j.src = p.w_in + (size_t)l * 1024 * 3872; j.dst = (bf16_t*)(p.ws + OFF_WT_IN); j.gain = p.norm_mix + l * 1024; j.K = 1024; j.N = 3872; j.mode = 1; break;
    case W_UQ: j.src = p.w_uq + (size_t)l * 256 * 576; j.dst = (bf16_t*)(p.ws + OFF_WT_UQ); j.gain = p.mla_q_norm + l * 256; j.K = 256; j.N = 576; j.mode = 2; break;
    case W_UK: j.src = p.w_uk + (size_t)l * 128 * 384; j.dst = (bf16_t*)(p.ws + OFF_WT_UKV); j.gain = p.mla_kv_norm + l * 128; j.K = 128; j.N = 384; break;
    case W_UV: j.src = p.w_uv + (size_t)l * 128 * 384; j.dst = (bf16_t*)(p.ws + OFF_WT_UKV) + 384 * 128; j.gain = p.mla_kv_norm + l * 128; j.K = 128; j.N = 384; break;
    case W_O: j.src = p.w_o + (size_t)l * 1024 * 1024; j.dst = (bf16_t*)(p.ws + OFF_WT_O); j.K = 1024; j.N = 1024; break;
    case W_CQ: j.src = p.w_cq + (size_t)l * 1024 * 1024; j.dst = (bf16_t*)(p.ws + OFF_WT_CQ); j.gain = p.norm_cross + l * 1024; j.K = 1024; j.N = 1024; break;
    case W_CO: j.src = p.w_co + (size_t)l * 1024 * 1024; j.dst = (bf16_t*)(p.ws + OFF_WT_CO); j.K = 1024; j.N = 1024; break;
    case W_UP: j.src = p.w_up + (size_t)l * 1024 * 5632; j.dst = (bf16_t*)(p.ws + OFF_WT_UP); j.gain = p.norm_ffn + l * 1024; j.K = 1024; j.N = 5632; j.mode = 3; break;
    case W_DOWN: j.src = p.w_down + (size_t)l * 2816 * 1024; j.dst = (bf16_t*)(p.ws + OFF_WT_DOWN); j.K = 2816; j.N = 1024; break;
    default: j.src = p.w_ckv + (size_t)l * 1024 * 2048; j.dst = (bf16_t*)(p.ws + OFF_WT_CKV); j.gain = p.norm_mem + l * 1024; j.K = 1024; j.N = 2048; break;
    }
    return j;
}
__device__ __forceinline__ void cvt_item(const P& p, int l, unsigned mask, int it, char* lds) {
    for (int w = 0; w < W_NUM; ++w) if (mask & (1u << w)) { const int n = cvt_tiles(w); if (it < n) { CvtJob j = get_cvt(p, l, w); cvt_tile(j, it, lds); return; } it -= n; }
}

struct SrcX {
    static constexpr bool F32 = true, SS = true;
    const float *p0, *p1; int split;
    __device__ __forceinline__ const float* row(int t) const { return (t < split ? p0 : p1) + (size_t)t * 1024; }
    __device__ __forceinline__ const float* ptrf(int t, int k0) const { return row(t) + k0; }
    __device__ __forceinline__ const bf16_t* ptrb(int, int) const { return nullptr; }
};
template <bool SS_> struct SrcB {
    static constexpr bool F32 = false, SS = SS_;
    const bf16_t* p; int ld;
    __device__ __forceinline__ const float* ptrf(int, int) const { return nullptr; }
    __device__ __forceinline__ const bf16_t* ptrb(int t, int k0) const { return p + (size_t)t * ld + k0; }
};
struct SrcMix {
    static constexpr bool F32 = false, SS = false;
    const bf16_t *mq, *naq, *dq;
    __device__ __forceinline__ const float* ptrf(int, int) const { return nullptr; }
    __device__ __forceinline__ const bf16_t* ptrb(int t, int k0) const {
        if (k0 < 384) return mq + (size_t)t * 576 + (k0 >> 6) * 96 + (k0 & 63);
        if (k0 < 768) return naq + (size_t)t * 384 + (k0 - 384);
        return dq + (size_t)t * 768 + (k0 - 768);
    }
};
struct TileCtx { int f0, tok0, wm, wn, l31, hh; float rs[2]; };

template <class Src, class Epi>
__device__ __forceinline__ void gemm_tile(const Src src, const bf16_t* __restrict__ Wt, const int K, const int f0, const int tok0, const int vlo, const int vhi,
                                          const Epi epi, char* lds) {
    const int tid = threadIdx.x, lane = tid & 63, wid = tid >> 6, wm = wid >> 1, wn = wid & 1, l31 = lane & 31, hh = lane >> 5;
    const int lr = tid >> 1, lh = tid & 1;
    bf16_t* sW = (bf16_t*)lds; bf16_t* sA = sW + 2 * 5120; float* ssb = (float*)(lds + LDS_SSB);
    const int trow = tok0 + lr; const bool rv = trow >= vlo && trow < vhi;
    const bf16_t* wp = Wt + (size_t)(f0 + lr) * K + lh * 16;
    u32x4 wr0, wr1, ar0 = {0, 0, 0, 0}, ar1 = {0, 0, 0, 0}; f32x4 af0 = {0, 0, 0, 0}, af1 = af0, af2 = af0, af3 = af0; float ss = 0.f;
    f32x16 acc[2][2];
#pragma unroll
    for (int i = 0; i < 2; ++i)
#pragma unroll
        for (int j = 0; j < 2; ++j)
#pragma unroll
            for (int r = 0; r < 16; ++r) acc[i][j][r] = 0.f;
    const int nk = K >> 5;
#define GLOAD(k0_) do { wr0 = *(const u32x4*)(wp + (k0_)); wr1 = *(const u32x4*)(wp + (k0_) + 8);                                              \
        if (Src::F32) { if (rv) { const float* ap = src.ptrf(trow, (k0_)) + lh * 16; af0 = *(const f32x4*)ap; af1 = *(const f32x4*)(ap + 4);     \
                af2 = *(const f32x4*)(ap + 8); af3 = *(const f32x4*)(ap + 12); } }                                                             \
        else { if (rv) { const bf16_t* ap = src.ptrb(trow, (k0_)) + lh * 16; ar0 = *(const u32x4*)ap; ar1 = *(const u32x4*)(ap + 8); } } } while (0)
#define LSTORE(buf_) do {                                                                                                                       \
        if (Src::F32) { if (Src::SS) { ss += af0[0] * af0[0] + af0[1] * af0[1] + af0[2] * af0[2] + af0[3] * af0[3] + af1[0] * af1[0] + af1[1] * af1[1] + af1[2] * af1[2] + af1[3] * af1[3] \
                    + af2[0] * af2[0] + af2[1] * af2[1] + af2[2] * af2[2] + af2[3] * af2[3] + af3[0] * af3[0] + af3[1] * af3[1] + af3[2] * af3[2] + af3[3] * af3[3]; }   \
            ar0 = (u32x4){pk2(af0[0], af0[1]), pk2(af0[2], af0[3]), pk2(af1[0], af1[1]), pk2(af1[2], af1[3])};                                   \
            ar1 = (u32x4){pk2(af2[0], af2[1]), pk2(af2[2], af2[3]), pk2(af3[0], af3[1]), pk2(af3[2], af3[3])}; }                                 \
        else if (Src::SS) { _Pragma("unroll") for (int e_ = 0; e_ < 4; ++e_) { float a_ = bflo(ar0[e_]), b_ = bfhi(ar0[e_]), c_ = bflo(ar1[e_]), d_ = bfhi(ar1[e_]); \
                ss += a_ * a_ + b_ * b_ + c_ * c_ + d_ * d_; } }                                                                                \
        bf16_t* pw_ = sW + (buf_) * 5120 + lr * 40 + lh * 16; *(u32x4*)pw_ = wr0; *(u32x4*)(pw_ + 8) = wr1;                                      \
        bf16_t* pa_ = sA + (buf_) * 5120 + lr * 40 + lh * 16; *(u32x4*)pa_ = ar0; *(u32x4*)(pa_ + 8) = ar1; } while (0)
    GLOAD(0);
    LSTORE(0);
    __syncthreads();
    for (int kt = 0; kt < nk; ++kt) {
        if (kt + 1 < nk) GLOAD((kt + 1) * 32);
        { const int buf = kt & 1;
          const bf16_t* bw = sW + buf * 5120 + (wm * 64 + l31) * 40 + hh * 8;
          const bf16_t* ba = sA + buf * 5120 + (wn * 64 + l31) * 40 + hh * 8;
#pragma unroll
          for (int ks = 0; ks < 2; ++ks) {
              const bf16x8 a0 = *(const bf16x8*)(bw + ks * 16), a1 = *(const bf16x8*)(bw + 32 * 40 + ks * 16);
              const bf16x8 b0 = *(const bf16x8*)(ba + ks * 16), b1 = *(const bf16x8*)(ba + 32 * 40 + ks * 16);
              acc[0][0] = MFMA32(a0, b0, acc[0][0]); acc[0][1] = MFMA32(a0, b1, acc[0][1]);
              acc[1][0] = MFMA32(a1, b0, acc[1][0]); acc[1][1] = MFMA32(a1, b1, acc[1][1]);
          } }
        if (kt + 1 < nk) LSTORE((kt + 1) & 1);
        __syncthreads();
    }
#undef GLOAD
#undef LSTORE
    TileCtx c; c.f0 = f0; c.tok0 = tok0; c.wm = wm; c.wn = wn; c.l31 = l31; c.hh = hh; c.rs[0] = 1.f; c.rs[1] = 1.f;
    if (Src::SS) {
        ss += __shfl_xor(ss, 1);
        if (lh == 0) ssb[lr] = ss;
        __syncthreads();
        const float invk = 1.0f / (float)K;
        c.rs[0] = rsqrtf(ssb[wn * 64 + l31] * invk + EPS); c.rs[1] = rsqrtf(ssb[wn * 64 + 32 + l31] * invk + EPS);
    }
    epi(acc, c, lds);
}

__device__ __forceinline__ void st4(bf16_t* p, float a, float b, float c, float d) { u32x2 w = {pk2(a, b), pk2(c, d)}; *(u32x2*)p = w; }

struct EpiIn {
    bf16_t *zc, *naq, *nak, *navT, *dq, *dk, *dvT; const float *na_qn, *na_kn, *dil_qn, *dil_kn; const f32x2* rope32;
    __device__ __forceinline__ void operator()(f32x16 (&acc)[2][2], const TileCtx& c, char*) const {
        const int fw = c.f0 + c.wm * 64;
        if (fw < 512) {
#pragma unroll
            for (int mt = 0; mt < 2; ++mt) { const int fb = fw + mt * 32; if (fb >= 416) continue;
#pragma unroll
                for (int nt = 0; nt < 2; ++nt) { const int t = c.tok0 + c.wn * 64 + nt * 32 + c.l31; const float rs = c.rs[nt];
#pragma unroll
                    for (int g = 0; g < 4; ++g) st4(zc + (size_t)t * 416 + fb + 8 * g + 4 * c.hh, acc[mt][nt][4 * g] * rs, acc[mt][nt][4 * g + 1] * rs, acc[mt][nt][4 * g + 2] * rs, acc[mt][nt][4 * g + 3] * rs); } }
        } else if (fw < 1664) {
            const int pf = fw - 512, which = pf / 384, head = (pf - which * 384) >> 6;
            if (which < 2) { const float* gain = which ? na_kn : na_qn; bf16_t* dst = which ? nak : naq;
#pragma unroll
                for (int nt = 0; nt < 2; ++nt) { const int t = c.tok0 + c.wn * 64 + nt * 32 + c.l31; const float rs = c.rs[nt]; float ss = 0.f;
#pragma unroll
                    for (int mt = 0; mt < 2; ++mt)
#pragma unroll
                        for (int r = 0; r < 16; ++r) { const float v = acc[mt][nt][r] * rs; acc[mt][nt][r] = v; ss += v * v; }
                    ss += __shfl_xor(ss, 32); const float rq = rsqrtf(ss * (1.f / 64.f) + EPS);
#pragma unroll
                    for (int mt = 0; mt < 2; ++mt)
#pragma unroll
                        for (int g = 0; g < 4; ++g) { const int d = mt * 32 + 8 * g + 4 * c.hh; const f32x4 gn = *(const f32x4*)(gain + d);
                            st4(dst + (size_t)t * 384 + head * 64 + d, acc[mt][nt][4 * g] * rq * gn[0], acc[mt][nt][4 * g + 1] * rq * gn[1], acc[mt][nt][4 * g + 2] * rq * gn[2], acc[mt][nt][4 * g + 3] * rq * gn[3]); } }
            } else {
#pragma unroll
                for (int nt = 0; nt < 2; ++nt) { const int t = c.tok0 + c.wn * 64 + nt * 32 + c.l31; const float rs = c.rs[nt];
#pragma unroll
                    for (int mt = 0; mt < 2; ++mt)
#pragma unroll
                        for (int r = 0; r < 16; ++r) navT[(size_t)(head * 64 + mt * 32 + crow(r, c.hh)) * T + t] = f2bf(acc[mt][nt][r] * rs); }
            }
        } else {
            const int pf = fw - 1664, which = pf / 768, h12 = (pf - which * 768) >> 6, g4 = h12 >> 2;
#pragma unroll
            for (int nt = 0; nt < 2; ++nt) { const int t = c.tok0 + c.wn * 64 + nt * 32 + c.l31; const float rs = c.rs[nt];
                int sbase, S; tokinfo(t, sbase, S); const int pos = t - sbase, sh = 2 * g4; const int tp = sbase + (pos & ((1 << sh) - 1)) * (S >> sh) + (pos >> sh);
                if (which < 2) { const float* gain = which ? dil_kn : dil_qn; bf16_t* dst = which ? dk : dq; float ss = 0.f;
#pragma unroll
                    for (int mt = 0; mt < 2; ++mt)
#pragma unroll
                        for (int r = 0; r < 16; ++r) { const float v = acc[mt][nt][r] * rs; acc[mt][nt][r] = v; ss += v * v; }
                    ss += __shfl_xor(ss, 32); const float rq = rsqrtf(ss * (1.f / 64.f) + EPS);
#pragma unroll
                    for (int g = 0; g < 4; ++g) { const int d = 8 * g + 4 * c.hh; const f32x4 g1 = *(const f32x4*)(gain + d), g2 = *(const f32x4*)(gain + 32 + d);
                        const f32x4 cs0 = *(const f32x4*)(rope32 + pos * 32 + d), cs1 = *(const f32x4*)(rope32 + pos * 32 + d + 2);
                        float o1[4], o2[4];
#pragma unroll
                        for (int j = 0; j < 4; ++j) { const float x1 = acc[0][nt][4 * g + j] * rq * g1[j], x2 = acc[1][nt][4 * g + j] * rq * g2[j];
                            const float cc = j < 2 ? cs0[2 * j] : cs1[2 * (j - 2)], sn = j < 2 ? cs0[2 * j + 1] : cs1[2 * (j - 2) + 1];
                            o1[j] = x1 * cc - x2 * sn; o2[j] = x2 * cc + x1 * sn; }
                        st4(dst + (size_t)tp * 768 + h12 * 64 + d, o1[0], o1[1], o1[2], o1[3]); st4(dst + (size_t)tp * 768 + h12 * 64 + 32 + d, o2[0], o2[1], o2[2], o2[3]); }
                } else {
#pragma unroll
                    for (int mt = 0; mt < 2; ++mt)
#pragma unroll
                        for (int r = 0; r < 16; ++r) dvT[(size_t)(h12 * 64 + mt * 32 + crow(r, c.hh)) * T + tp] = f2bf(acc[mt][nt][r] * rs);
                } }
        }
    }
};

struct EpiUq {
    bf16_t* mq; const float* qn; const f32x2* rope16;
    __device__ __forceinline__ void operator()(f32x16 (&acc)[2][2], const TileCtx& c, char* lds) const {
        float* ssx = (float*)(lds + LDS_SSX); const int head = c.f0 >> 7;
#pragma unroll
        for (int nt = 0; nt < 2; ++nt) { float ss = 0.f;
#pragma unroll
            for (int mt = 0; mt < 2; ++mt) { if (c.wm == 1 && mt == 1) continue;
#pragma unroll
                for (int r = 0; r < 16; ++r) { const float v = acc[mt][nt][r] * c.rs[nt]; acc[mt][nt][r] = v; ss += v * v; } }
            ss += __shfl_xor(ss, 32); if (c.hh == 0) ssx[c.wm * 128 + c.wn * 64 + nt * 32 + c.l31] = ss; }
        __syncthreads();
#pragma unroll
        for (int nt = 0; nt < 2; ++nt) { const int tl = c.wn * 64 + nt * 32 + c.l31, t = c.tok0 + tl; const float rq = rsqrtf((ssx[tl] + ssx[128 + tl]) * (1.f / 96.f) + EPS);
            int sbase, S; tokinfo(t, sbase, S); const int pos = t - sbase; bf16_t* dst = mq + (size_t)t * 576 + head * 96 + c.wm * 64;
            if (c.wm == 0) {
#pragma unroll
                for (int mt = 0; mt < 2; ++mt)
#pragma unroll
                    for (int g = 0; g < 4; ++g) { const int d = mt * 32 + 8 * g + 4 * c.hh; const f32x4 gn = *(const f32x4*)(qn + d);
                        st4(dst + d, acc[mt][nt][4 * g] * rq * gn[0], acc[mt][nt][4 * g + 1] * rq * gn[1], acc[mt][nt][4 * g + 2] * rq * gn[2], acc[mt][nt][4 * g + 3] * rq * gn[3]); }
            } else {
#pragma unroll
                for (int g = 0; g < 2; ++g) { const int i = 8 * g + 4 * c.hh; const f32x4 g1 = *(const f32x4*)(qn + 64 + i), g2 = *(const f32x4*)(qn + 80 + i);
                    const f32x4 cs0 = *(const f32x4*)(rope16 + pos * 16 + i), cs1 = *(const f32x4*)(rope16 + pos * 16 + i + 2); float o1[4], o2[4];
#pragma unroll
                    for (int j = 0; j < 4; ++j) { const float x1 = acc[0][nt][4 * g + j] * rq * g1[j], x2 = acc[0][nt][8 + 4 * g + j] * rq * g2[j];
                        const float cc = j < 2 ? cs0[2 * j] : cs1[2 * (j - 2)], sn = j < 2 ? cs0[2 * j + 1] : cs1[2 * (j - 2) + 1];
                        o1[j] = x1 * cc - x2 * sn; o2[j] = x2 * cc + x1 * sn; }
                    st4(dst + i, o1[0], o1[1], o1[2], o1[3]); st4(dst + 16 + i, o2[0], o2[1], o2[2], o2[3]); }
            } }
    }
};

struct EpiUkv {
    bf16_t *mk, *mvT; const bf16_t* zc; const float* kn; const f32x2* rope16;
    __device__ __forceinline__ void operator()(f32x16 (&acc)[2][2], const TileCtx& c, char*) const {
        const int fw = c.f0 + c.wm * 64;
        if (fw < 384) { const int head = fw >> 6;
#pragma unroll
            for (int nt = 0; nt < 2; ++nt) { const int t = c.tok0 + c.wn * 64 + nt * 32 + c.l31; const float rs = c.rs[nt]; float ss = 0.f;
#pragma unroll
                for (int mt = 0; mt < 2; ++mt)
#pragma unroll
                    for (int r = 0; r < 16; ++r) { const float v = acc[mt][nt][r] * rs; acc[mt][nt][r] = v; ss += v * v; }
                const bf16_t* krp = zc + (size_t)t * 416 + 384 + 8 * c.hh; const u32x4 ka = *(const u32x4*)krp, kb = *(const u32x4*)(krp + 16);
                float x1[8], x2[8];
#pragma unroll
                for (int e = 0; e < 4; ++e) { x1[2 * e] = bflo(ka[e]); x1[2 * e + 1] = bfhi(ka[e]); x2[2 * e] = bflo(kb[e]); x2[2 * e + 1] = bfhi(kb[e]); }
#pragma unroll
                for (int e = 0; e < 8; ++e) ss += x1[e] * x1[e] + x2[e] * x2[e];
                ss += __shfl_xor(ss, 32); const float rq = rsqrtf(ss * (1.f / 96.f) + EPS);
                int sbase, S; tokinfo(t, sbase, S); const int pos = t - sbase; bf16_t* dst = mk + (size_t)t * 576 + head * 96;
#pragma unroll
                for (int mt = 0; mt < 2; ++mt)
#pragma unroll
                    for (int g = 0; g < 4; ++g) { const int d = mt * 32 + 8 * g + 4 * c.hh; const f32x4 gn = *(const f32x4*)(kn + d);
                        st4(dst + d, acc[mt][nt][4 * g] * rq * gn[0], acc[mt][nt][4 * g + 1] * rq * gn[1], acc[mt][nt][4 * g + 2] * rq * gn[2], acc[mt][nt][4 * g + 3] * rq * gn[3]); }
                float o1[8], o2[8];
#pragma unroll
                for (int e = 0; e < 8; ++e) { const int i = 8 * c.hh + e; const f32x2 cs = rope16[pos * 16 + i]; const float a = x1[e] * rq * kn[64 + i], b = x2[e] * rq * kn[80 + i];
                    o1[e] = a * cs[0] - b * cs[1]; o2[e] = b * cs[0] + a * cs[1]; }
                u32x4 w1 = {pk2(o1[0], o1[1]), pk2(o1[2], o1[3]), pk2(o1[4], o1[5]), pk2(o1[6], o1[7])}, w2 = {pk2(o2[0], o2[1]), pk2(o2[2], o2[3]), pk2(o2[4], o2[5]), pk2(o2[6], o2[7])};
                *(u32x4*)(dst + 64 + 8 * c.hh) = w1; *(u32x4*)(dst + 80 + 8 * c.hh) = w2; }
        } else { const int head = (fw - 384) >> 6;
#pragma unroll
            for (int nt = 0; nt < 2; ++nt) { const int t = c.tok0 + c.wn * 64 + nt * 32 + c.l31; const float rs = c.rs[nt];
#pragma unroll
                for (int mt = 0; mt < 2; ++mt)
#pragma unroll
                    for (int r = 0; r < 16; ++r) mvT[(size_t)(head * 64 + mt * 32 + crow(r, c.hh)) * T + t] = f2bf(acc[mt][nt][r] * rs); }
        }
    }
};

struct EpiRes {
    SrcX xin; float* out;
    __device__ __forceinline__ void operator()(f32x16 (&acc)[2][2], const TileCtx& c, char*) const {
#pragma unroll
        for (int nt = 0; nt < 2; ++nt) { const int t = c.tok0 + c.wn * 64 + nt * 32 + c.l31; const float* xr = xin.row(t); float* orow = out + (size_t)t * 1024;
#pragma unroll
            for (int mt = 0; mt < 2; ++mt)
#pragma unroll
                for (int g = 0; g < 4; ++g) { const int f = c.f0 + c.wm * 64 + mt * 32 + 8 * g + 4 * c.hh; f32x4 v = *(const f32x4*)(xr + f);
                    v[0] += acc[mt][nt][4 * g]; v[1] += acc[mt][nt][4 * g + 1]; v[2] += acc[mt][nt][4 * g + 2]; v[3] += acc[mt][nt][4 * g + 3]; *(f32x4*)(orow + f) = v; } }
    }
};

struct EpiBf {
    bf16_t* dst; int ld;
    __device__ __forceinline__ void operator()(f32x16 (&acc)[2][2], const TileCtx& c, char*) const {
#pragma unroll
        for (int nt = 0; nt < 2; ++nt) { const int t = c.tok0 + c.wn * 64 + nt * 32 + c.l31; const float rs = c.rs[nt];
#pragma unroll
            for (int mt = 0; mt < 2; ++mt)
#pragma unroll
                for (int g = 0; g < 4; ++g) { const int f = c.f0 + c.wm * 64 + mt * 32 + 8 * g + 4 * c.hh;
                    st4(dst + (size_t)t * ld + f, acc[mt][nt][4 * g] * rs, acc[mt][nt][4 * g + 1] * rs, acc[mt][nt][4 * g + 2] * rs, acc[mt][nt][4 * g + 3] * rs); } }
    }
};

struct EpiMem {
    bf16_t *memK, *memVT; float* memss; const float *xkn, *xqn;
    __device__ __forceinline__ void operator()(f32x16 (&acc)[2][2], const TileCtx& c, char*) const {
        const int fw = c.f0 + c.wm * 64;
#pragma unroll
        for (int nt = 0; nt < 2; ++nt) { const int m = c.tok0 + c.wn * 64 + nt * 32 + c.l31; const float rs = c.rs[nt];
            if (fw < 1024) { float ss = 0.f;
#pragma unroll
                for (int mt = 0; mt < 2; ++mt)
#pragma unroll
                    for (int r = 0; r < 16; ++r) { const float v = acc[mt][nt][r] * rs; acc[mt][nt][r] = v; ss += v * v; }
                ss += __shfl_xor(ss, 32); if (c.hh == 0) memss[m * 16 + (fw >> 6)] = ss;
#pragma unroll
                for (int mt = 0; mt < 2; ++mt)
#pragma unroll
                    for (int g = 0; g < 4; ++g) { const int f = fw + mt * 32 + 8 * g + 4 * c.hh, d = f & 255; const f32x4 gk = *(const f32x4*)(xkn + d), gq = *(const f32x4*)(xqn + d);
                        st4(memK + (size_t)m * 1024 + f, acc[mt][nt][4 * g] * gk[0] * gq[0] * 0.0625f, acc[mt][nt][4 * g + 1] * gk[1] * gq[1] * 0.0625f,
                            acc[mt][nt][4 * g + 2] * gk[2] * gq[2] * 0.0625f, acc[mt][nt][4 * g + 3] * gk[3] * gq[3] * 0.0625f); }
            } else { const int b = m >> 8, key = m & 255;
#pragma unroll
                for (int mt = 0; mt < 2; ++mt)
#pragma unroll
                    for (int r = 0; r < 16; ++r) memVT[((size_t)(b * 1024 + fw - 1024 + mt * 32 + crow(r, c.hh)) << 8) + key] = f2bf(acc[mt][nt][r] * rs);
            } }
    }
};

struct EpiFfn {
    bf16_t* act; const float *cw, *cb; int sbase, S, pos0, ft;
    __device__ __forceinline__ void operator()(f32x16 (&acc)[2][2], const TileCtx& c, char* lds) const {
        float* U = (float*)lds;
#pragma unroll
        for (int nt = 0; nt < 2; ++nt) { const int tl = c.wn * 64 + nt * 32 + c.l31; const float rs = c.rs[nt];
#pragma unroll
            for (int mt = 0; mt < 2; ++mt)
#pragma unroll
                for (int r = 0; r < 16; ++r) U[tl * 129 + c.wm * 64 + mt * 32 + crow(r, c.hh)] = acc[mt][nt][r] * rs; }
        __syncthreads();
        { const int tid = threadIdx.x, f = tid & 63, tq = tid >> 6, fa = ft * 64 + f, fg = 2816 + fa;
          const float a0 = cw[fa], a1 = cw[5632 + fa], a2 = cw[2 * 5632 + fa], ab = cb[fa], g0 = cw[fg], g1 = cw[5632 + fg], g2 = cw[2 * 5632 + fg], gb = cb[fg];
          const int i0 = 1 + tq * 32; int i1 = i0 + 32; if (i1 > 127) i1 = 127;
          float pa = U[(i0 - 1) * 129 + f], ca = U[i0 * 129 + f], pg = U[(i0 - 1) * 129 + 64 + f], cg_ = U[i0 * 129 + 64 + f];
          for (int i = i0; i < i1; ++i) { const float na = U[(i + 1) * 129 + f], ng = U[(i + 1) * 129 + 64 + f];
              const float ua = a0 * pa + a1 * ca + a2 * na + ab, ug = g0 * pg + g1 * cg_ + g2 * ng + gb;
              const float y = ua * ug / (1.f + __expf(-ug)); const int pos = pos0 + i;
              if (pos < S) act[(size_t)(sbase + pos) * 2816 + fa] = f2bf(y);
              pa = ca; ca = na; pg = cg_; cg_ = ng; } }
        __syncthreads();
    }
};

template <int NKS, int NDT, class Hook>
__device__ __forceinline__ void attn_wave(const bf16_t* __restrict__ qrow, const bf16_t* __restrict__ kb, const int kstride, const bf16_t* __restrict__ vT, const size_t vstride,
                                          const int sub_lo, const int sub_hi, Hook& hook, f32x16 (&O)[NDT], float& m_out, float& l_out) {
    const int lane = threadIdx.x & 63, l31 = lane & 31, hh = lane >> 5;
    bf16x8 qf[NKS];
#pragma unroll
    for (int ks = 0; ks < NKS; ++ks) qf[ks] = *(const bf16x8*)(qrow + ks * 16 + hh * 8);
    hook.init(qf);
    float m = -1e30f, lsum = 0.f;
#pragma unroll
    for (int dt = 0; dt < NDT; ++dt)
#pragma unroll
        for (int r = 0; r < 16; ++r) O[dt][r] = 0.f;
    for (int sub = sub_lo; sub < sub_hi; ++sub) {
        const bf16_t* kp = kb + (size_t)(sub * 32 + l31) * kstride + hh * 8;
        f32x16 s;
#pragma unroll
        for (int r = 0; r < 16; ++r) s[r] = 0.f;
#pragma unroll
        for (int ks = 0; ks < NKS; ++ks) s = MFMA32(*(const bf16x8*)(kp + ks * 16), qf[ks], s);
        hook.apply(s, sub);
        float mx = s[0];
#pragma unroll
        for (int r = 1; r < 16; ++r) mx = fmaxf(mx, s[r]);
        mx = fmaxf(mx, __shfl_xor(mx, 32));
        const float mn = fmaxf(m, mx), alpha = __builtin_amdgcn_exp2f(m - mn); m = mn;
        float ps = 0.f;
#pragma unroll
        for (int r = 0; r < 16; ++r) { s[r] = __builtin_amdgcn_exp2f(s[r] - mn); ps += s[r]; }
        lsum = lsum * alpha + ps;
        u32x4 w0 = {pk2(s[0], s[1]), pk2(s[2], s[3]), pk2(s[4], s[5]), pk2(s[6], s[7])}, w1 = {pk2(s[8], s[9]), pk2(s[10], s[11]), pk2(s[12], s[13]), pk2(s[14], s[15])};
        const bf16x8 pf0 = *(bf16x8*)&w0, pf1 = *(bf16x8*)&w1;
#pragma unroll
        for (int dt = 0; dt < NDT; ++dt) {
            const bf16_t* vp = vT + (size_t)(dt * 32 + l31) * vstride + sub * 32 + hh * 4;
            const s16x4 a0 = *(const s16x4*)vp, a1 = *(const s16x4*)(vp + 8), b0 = *(const s16x4*)(vp + 16), b1 = *(const s16x4*)(vp + 24);
#pragma unroll
            for (int r = 0; r < 16; ++r) O[dt][r] *= alpha;
            const bf16x8 va = {a0[0], a0[1], a0[2], a0[3], a1[0], a1[1], a1[2], a1[3]}, vb = {b0[0], b0[1], b0[2], b0[3], b1[0], b1[1], b1[2], b1[3]};
            O[dt] = MFMA32(va, pf0, O[dt]); O[dt] = MFMA32(vb, pf1, O[dt]);
        }
    }
    l_out = lsum + __shfl_xor(lsum, 32); m_out = m;
}
template <int NDT>
__device__ __forceinline__ void attn_store(bf16_t* orow, const f32x16 (&O)[NDT], float l) {
    const int hh = (threadIdx.x & 63) >> 5; const float inv = 1.f / l;
#pragma unroll
    for (int dt = 0; dt < NDT; ++dt)
#pragma unroll
        for (int g = 0; g < 4; ++g) st4(orow + dt * 32 + 8 * g + 4 * hh, O[dt][4 * g] * inv, O[dt][4 * g + 1] * inv, O[dt][4 * g + 2] * inv, O[dt][4 * g + 3] * inv);
}

struct HookDense { float sc;
    template <class Q> __device__ __forceinline__ void init(Q&) {}
    __device__ __forceinline__ void apply(f32x16& s, int) const {
#pragma unroll
        for (int r = 0; r < 16; ++r) s[r] *= sc; } };
struct HookNA { const float* rpb; int c, cs, joff, hh;
    template <class Q> __device__ __forceinline__ void init(Q&) {}
    __device__ __forceinline__ void apply(f32x16& s, int sub) const { const int j = sub >> 1, cb = (sub & 1) * 32; const float* row = rpb + (joff + j) * 31 + 15 - c;
#pragma unroll
        for (int r = 0; r < 16; ++r) { const int col = cb + crow(r, hh); const bool v = (unsigned)(col - cs) < 16u; const float b = v ? row[col] : 0.f;
            s[r] = v ? (s[r] * 0.125f + b) * LOG2E : -1e30f; } } };
struct HookDil { int qv, hh;
    template <class Q> __device__ __forceinline__ void init(Q&) {}
    __device__ __forceinline__ void apply(f32x16& s, int sub) const {
#pragma unroll
        for (int r = 0; r < 16; ++r) { int d = sub * 32 + crow(r, hh) - qv; d = d < 0 ? -d : d; s[r] = d <= 64 ? s[r] * (0.125f * LOG2E) : -1e30f; } } };
struct HookX { const float* ss; int hh; float rq;
    template <class Q> __device__ __forceinline__ void init(Q& qf) { float a = 0.f;
#pragma unroll
        for (int ks = 0; ks < 16; ++ks)
#pragma unroll
            for (int e = 0; e < 8; ++e) { const float v = __uint_as_float(((unsigned)(unsigned short)qf[ks][e]) << 16); a += v * v; }
        a += __shfl_xor(a, 32); rq = rsqrtf(a * (1.f / 256.f) + EPS) * LOG2E; }
    __device__ __forceinline__ void apply(f32x16& s, int sub) const {
#pragma unroll
        for (int r = 0; r < 16; ++r) { const f32x4 q = *(const f32x4*)(ss + (sub * 32 + crow(r, hh)) * 16); const float rk = rsqrtf((q[0] + q[1] + q[2] + q[3]) * (1.f / 256.f) + EPS);
            s[r] *= rq * rk; } } };

__device__ __forceinline__ SrcX xsrc(const P& p, int l, bool after_mix) {
    SrcX s; if (l == 0 && !after_mix) { s.p0 = p.xp; s.p1 = p.xs - (size_t)NPR * 1024; s.split = NPR; } else { s.p0 = p.out; s.p1 = p.out; s.split = T; } return s;
}

__device__ void phase0(const P& p, char* lds) {
    constexpr unsigned mask = (1u << W_NUM) - 1;
    const int ncv = cvt_count(mask), nrope = 8192 * 48 / 256;
    for (int it = blockIdx.x; it < ncv + nrope; it += gridDim.x) {
        if (it < ncv) cvt_item(p, 0, mask, it, lds);
        else { const int idx = (it - ncv) * 256 + threadIdx.x; int pos, i; float inv; f32x2* dst;
            if (idx < 8192 * 32) { pos = idx >> 5; i = idx & 31; inv = p.inv32[i]; dst = (f32x2*)(p.ws + OFF_ROPE32) + idx; }
            else { const int k = idx - 8192 * 32; pos = k >> 4; i = k & 15; inv = p.inv16[i]; dst = (f32x2*)(p.ws + OFF_ROPE16) + k; }
            const float ang = (float)pos * inv; const double tr = (double)ang * 0.15915494309189535; const float fr = (float)(tr - rint(tr));
            f32x2 cs = {__builtin_amdgcn_cosf(fr), __builtin_amdgcn_sinf(fr)}; *dst = cs; }
    }
}

__device__ void phaseA(const P& p, int l, char* lds) {
    const unsigned mask = l > 0 ? (1u << W_DOWN) : 0u; const int ncv = (cvt_count(mask) + 7) & ~7;
    const int nmem = swz_count(20, 16), nin = swz_count(256, 31);
    char* ws = p.ws;
    for (int it = blockIdx.x; it < ncv + nmem + nin; it += gridDim.x) {
        if (it < ncv) { if (it < cvt_count(mask)) cvt_item(p, l, mask, it, lds); }
        else if (it < ncv + nmem) { int mt, nt; if (!swz(it - ncv, 20, 16, mt, nt)) continue;
            SrcX s; s.p0 = p.memp; s.p1 = p.mems - (size_t)2048 * 1024; s.split = 2048;
            EpiMem e; e.memK = (bf16_t*)(ws + OFF_MEMK); e.memVT = (bf16_t*)(ws + OFF_MEMVT); e.memss = (float*)(ws + OFF_MEMSS); e.xkn = p.x_kn + l * 256; e.xqn = p.x_qn + l * 256;
            gemm_tile(s, (const bf16_t*)(ws + OFF_WT_CKV), 1024, nt * 128, mt * 128, 0, 2560, e, lds); }
        else { int mt, nt; if (!swz(it - ncv - nmem, 256, 31, mt, nt)) continue;
            EpiIn e; e.zc = (bf16_t*)(ws + OFF_ZC); e.naq = (bf16_t*)(ws + OFF_NAQ); e.nak = (bf16_t*)(ws + OFF_NAK); e.navT = (bf16_t*)(ws + OFF_NAVT);
            e.dq = (bf16_t*)(ws + OFF_DQ); e.dk = (bf16_t*)(ws + OFF_DK); e.dvT = (bf16_t*)(ws + OFF_DVT);
            e.na_qn = p.na_qn + l * 64; e.na_kn = p.na_kn + l * 64; e.dil_qn = p.dil_qn + l * 64; e.dil_kn = p.dil_kn + l * 64; e.rope32 = (const f32x2*)(ws + OFF_ROPE32);
            gemm_tile(xsrc(p, l, false), (const bf16_t*)(ws + OFF_WT_IN), 1024, nt * 128, mt * 128, 0, T, e, lds); }
    }
}

__device__ void phaseB(const P& p, int l, char* lds) {
    char* ws = p.ws; const int nuq = swz_count(256, 6), nukv = swz_count(256, 6), nna = 512 * 3, ndil = 12 * 256;
    const int wid = threadIdx.x >> 6, lane = threadIdx.x & 63, l31 = lane & 31, hh = lane >> 5;
    for (int it = blockIdx.x; it < nuq + nukv + nna + ndil; it += gridDim.x) {
        if (it < nuq) { int mt, nt; if (!swz(it, 256, 6, mt, nt)) continue;
            SrcB<true> s; s.p = (const bf16_t*)(ws + OFF_ZC); s.ld = 416;
            EpiUq e; e.mq = (bf16_t*)(ws + OFF_MQ); e.qn = p.mla_qn + l * 96; e.rope16 = (const f32x2*)(ws + OFF_ROPE16);
            gemm_tile(s, (const bf16_t*)(ws + OFF_WT_UQ), 256, nt * 128, mt * 128, 0, T, e, lds); }
        else if (it < nuq + nukv) { int mt, nt; if (!swz(it - nuq, 256, 6, mt, nt)) continue;
            SrcB<true> s; s.p = (const bf16_t*)(ws + OFF_ZC) + 256; s.ld = 416;
            EpiUkv e; e.mk = (bf16_t*)(ws + OFF_MK); e.mvT = (bf16_t*)(ws + OFF_MVT); e.zc = (const bf16_t*)(ws + OFF_ZC); e.kn = p.mla_kn + l * 96; e.rope16 = (const f32x2*)(ws + OFF_ROPE16);
            gemm_tile(s, (const bf16_t*)(ws + OFF_WT_UKV), 128, nt * 128, mt * 128, 0, T, e, lds); }
        else if (it < nuq + nukv + nna) { const int bi = it - nuq - nukv, R = bi / 3, hp = bi - R * 3, head = hp * 2 + (wid >> 1), ch = wid & 1;
            const int tR = R * 64; int sbase, S; tokinfo(tR, sbase, S); const int r = (tR - sbase) >> 6, rows = S >> 6;
            int rs = r - 4; rs = rs < 0 ? 0 : rs; rs = rs > rows - 8 ? rows - 8 : rs; const int kbase = sbase + rs * 64;
            bf16_t* naq = (bf16_t*)(ws + OFF_NAQ); bf16_t* qrow = naq + (size_t)(tR + ch * 32 + l31) * 384 + head * 64;
            HookNA hk; hk.rpb = p.na_rpb + ((size_t)l * 6 + head) * 465; hk.c = ch * 32 + l31; int cs = hk.c - 8; cs = cs < 0 ? 0 : cs; cs = cs > 48 ? 48 : cs; hk.cs = cs; hk.joff = rs - r + 7; hk.hh = hh;
            f32x16 O[2]; float m, lsum;
            attn_wave<4, 2>(qrow, (const bf16_t*)(ws + OFF_NAK) + (size_t)kbase * 384 + head * 64, 384, (const bf16_t*)(ws + OFF_NAVT) + (size_t)(head * 64) * T + kbase, (size_t)T, 0, 16, hk, O, m, lsum);
            attn_store<2>(qrow, O, lsum); }
        else { const int bi = it - nuq - nukv - nna, h12 = bi >> 8, qi = (bi & 255) * 4 + wid, g = h12 >> 2, tp0 = qi * 32;
            int sbase, S; tokinfo(tp0, sbase, S); const int L = S >> (2 * g), off = tp0 - sbase, rho = off / L, i0 = off - rho * L, vsb = sbase + rho * L;
            int slo = (i0 - 64) >> 5; slo = slo < 0 ? 0 : slo; int shi = (i0 + 96) >> 5; shi = shi > (L >> 5) ? (L >> 5) : shi;
            bf16_t* dq = (bf16_t*)(ws + OFF_DQ); bf16_t* qrow = dq + (size_t)(tp0 + l31) * 768 + h12 * 64;
            HookDil hk; hk.qv = i0 + l31; hk.hh = hh; f32x16 O[2]; float m, lsum;
            attn_wave<4, 2>(qrow, (const bf16_t*)(ws + OFF_DK) + (size_t)vsb * 768 + h12 * 64, 768, (const bf16_t*)(ws + OFF_DVT) + (size_t)(h12 * 64) * T + vsb, (size_t)T, slo, shi, hk, O, m, lsum);
            attn_store<2>(qrow, O, lsum);
            if (hh == 0) { const int tn = sbase + ((i0 + l31) << (2 * g)) + rho; ((float*)(ws + OFF_LSE))[(size_t)tn * 12 + h12] = (m + __log2f(lsum)) * 0.6931471805599453f; } }
    }
}

__device__ void phaseC(const P& p, int l, char* lds) {
    char* ws = p.ws; const unsigned mask = l < 3 ? ((1u << W_IN) | (1u << W_UQ) | (1u << W_UK) | (1u << W_UV) | (1u << W_CKV)) : 0u;
    const int ndense = 1536, ncomb = 4096, ncv = cvt_count(mask);
    const int wid = threadIdx.x >> 6, lane = threadIdx.x & 63, l31 = lane & 31;
    for (int it = blockIdx.x; it < ndense + ncomb + ncv; it += gridDim.x) {
        if (it < ndense) { int sbase, S, head, qb;
            if (it < 768) { const int sq = it / 384, rem = it - sq * 384; head = rem >> 6; qb = rem & 63; sbase = NPR + sq * 8192; S = 8192; }
            else { const int k = it - 768, sq = k / 96, rem = k - sq * 96; head = rem >> 4; qb = rem & 15; sbase = sq * 2048; S = 2048; }
            bf16_t* mq = (bf16_t*)(ws + OFF_MQ); bf16_t* qrow = mq + (size_t)(sbase + qb * 128 + wid * 32 + l31) * 576 + head * 96;
            HookDense hk; hk.sc = 0.10206207261596575f * LOG2E; f32x16 O[2]; float m, lsum;
            attn_wave<6, 2>(qrow, (const bf16_t*)(ws + OFF_MK) + (size_t)sbase * 576 + head * 96, 576, (const bf16_t*)(ws + OFF_MVT) + (size_t)(head * 64) * T + sbase, (size_t)T, 0, S >> 5, hk, O, m, lsum);
            attn_store<2>(qrow, O, lsum); }
        else if (it < ndense + ncomb) { const int idx = (it - ndense) * 256 + threadIdx.x, cch = idx & 7, hs = (idx >> 3) & 3, t = idx >> 5;
            const float* lse = (const float*)(ws + OFF_LSE) + (size_t)t * 12 + hs; const float l0 = lse[0], l1 = lse[4], l2 = lse[8];
            const float M = fmaxf(l0, fmaxf(l1, l2)); float w0 = __expf(l0 - M), w1 = __expf(l1 - M), w2 = __expf(l2 - M); const float iw = 1.f / (w0 + w1 + w2); w0 *= iw; w1 *= iw; w2 *= iw;
            bf16_t* dq = (bf16_t*)(ws + OFF_DQ);
            const u32x4 a = *(const u32x4*)(dq + (size_t)t * 768 + hs * 64 + cch * 8), b = *(const u32x4*)(dq + (size_t)permtok(t, 1) * 768 + (4 + hs) * 64 + cch * 8),
                        c = *(const u32x4*)(dq + (size_t)permtok(t, 2) * 768 + (8 + hs) * 64 + cch * 8);
            u32x4 o;
#pragma unroll
            for (int e = 0; e < 4; ++e) o[e] = pk2(w0 * bflo(a[e]) + w1 * bflo(b[e]) + w2 * bflo(c[e]), w0 * bfhi(a[e]) + w1 * bfhi(b[e]) + w2 * bfhi(c[e]));
            *(u32x4*)(dq + (size_t)t * 768 + hs * 64 + cch * 8) = o; }
        else cvt_item(p, l + 1, mask, it - ndense - ncomb, lds);
    }
}

__device__ void phaseD(const P& p, int l, char* lds) {
    char* ws = p.ws; const int n = swz_count(256, 8);
    for (int it = blockIdx.x; it < n; it += gridDim.x) { int mt, nt; if (!swz(it, 256, 8, mt, nt)) continue;
        SrcMix s; s.mq = (const bf16_t*)(ws + OFF_MQ); s.naq = (const bf16_t*)(ws + OFF_NAQ); s.dq = (const bf16_t*)(ws + OFF_DQ);
        EpiRes e; e.xin = xsrc(p, l, false); e.out = p.out;
        gemm_tile(s, (const bf16_t*)(ws + OFF_WT_O), 1024, nt * 128, mt * 128, 0, T, e, lds); }
}
__device__ void phaseE1(const P& p, int l, char* lds) {
    char* ws = p.ws; const int n = swz_count(256, 8);
    for (int it = blockIdx.x; it < n; it += gridDim.x) { int mt, nt; if (!swz(it, 256, 8, mt, nt)) continue;
        EpiBf e; e.dst = (bf16_t*)(ws + OFF_XQ); e.ld = 1024;
        gemm_tile(xsrc(p, l, true), (const bf16_t*)(ws + OFF_WT_CQ), 1024, nt * 128, mt * 128, 0, T, e, lds); }
}
__device__ void phaseE2(const P& p, int l, char* lds) {
    char* ws = p.ws; const unsigned mask = l < 3 ? ((1u << W_O) | (1u << W_CQ)) : 0u; const int nx = 2048, ncv = cvt_count(mask);
    const int wid = threadIdx.x >> 6, lane = threadIdx.x & 63, l31 = lane & 31, hh = lane >> 5;
    for (int it = blockIdx.x; it < nx + ncv; it += gridDim.x) {
        if (it < nx) { const int dh = it & 1, head = (it >> 1) & 3, tb = it >> 3, t0 = tb * 128 + wid * 32, t = t0 + l31;
            const int batch = t0 < NPR ? (t0 >> 11) : 8 + ((t0 - NPR) >> 13);
            const bf16_t* qrow = (const bf16_t*)(ws + OFF_XQ) + (size_t)t * 1024 + head * 256;
            HookX hk; hk.ss = (const float*)(ws + OFF_MEMSS) + (size_t)(batch * 256) * 16 + head * 4; hk.hh = hh; hk.rq = 0.f; f32x16 O[4]; float m, lsum;
            attn_wave<16, 4>(qrow, (const bf16_t*)(ws + OFF_MEMK) + (size_t)(batch * 256) * 1024 + head * 256, 1024,
                             (const bf16_t*)(ws + OFF_MEMVT) + ((size_t)(batch * 1024 + head * 256 + dh * 128) << 8), (size_t)256, 0, 8, hk, O, m, lsum);
            attn_store<4>((bf16_t*)(ws + OFF_XO) + (size_t)t * 1024 + head * 256 + dh * 128, O, lsum); }
        else cvt_item(p, l + 1, mask, it - nx, lds);
    }
}
__device__ void phaseE3(const P& p, int l, char* lds) {
    char* ws = p.ws; const int n = swz_count(256, 8);
    for (int it = blockIdx.x; it < n; it += gridDim.x) { int mt, nt; if (!swz(it, 256, 8, mt, nt)) continue;
        SrcB<false> s; s.p = (const bf16_t*)(ws + OFF_XO); s.ld = 1024;
        EpiRes e; e.xin = xsrc(p, l, true); e.out = p.out;
        gemm_tile(s, (const bf16_t*)(ws + OFF_WT_CO), 1024, nt * 128, mt * 128, 0, T, e, lds); }
}
__device__ void phaseF1(const P& p, int l, char* lds) {
    char* ws = p.ws; const int n = swz_count(268, 44);
    for (int it = blockIdx.x; it < n; it += gridDim.x) { int mt, nt; if (!swz(it, 268, 44, mt, nt)) continue;
        int sbase, S, m; if (mt < 136) { const int sq = mt / 17; m = mt - sq * 17; sbase = sq * 2048; S = 2048; } else { const int k = mt - 136, sq = k / 66; m = k - sq * 66; sbase = NPR + sq * 8192; S = 8192; }
        EpiFfn e; e.act = (bf16_t*)(ws + OFF_ACT); e.cw = p.conv_w + (size_t)l * 3 * 5632; e.cb = p.conv_b + (size_t)l * 5632; e.sbase = sbase; e.S = S; e.pos0 = 126 * m - 1; e.ft = nt;
        gemm_tile(xsrc(p, l, true), (const bf16_t*)(ws + OFF_WT_UP), 1024, nt * 128, sbase + 126 * m - 1, sbase, sbase + S, e, lds); }
}
__device__ void phaseF2(const P& p, int l, char* lds) {
    char* ws = p.ws; const unsigned mask = l < 3 ? ((1u << W_CO) | (1u << W_UP)) : 0u; const int n = swz_count(256, 8), ncv = cvt_count(mask);
    for (int it = blockIdx.x; it < n + ncv; it += gridDim.x) {
        if (it < n) { int mt, nt; if (!swz(it, 256, 8, mt, nt)) continue;
            SrcB<false> s; s.p = (const bf16_t*)(ws + OFF_ACT); s.ld = 2816;
            EpiRes e; e.xin = xsrc(p, l, true); e.out = p.out;
            gemm_tile(s, (const bf16_t*)(ws + OFF_WT_DOWN), 2816, nt * 128, mt * 128, 0, T, e, lds); }
        else cvt_item(p, l + 1, mask, it - n, lds);
    }
}

__global__ void __launch_bounds__(256, 1) mega(const P p) {
    __shared__ __attribute__((aligned(16))) char lds[LDS_BYTES];
    cg::grid_group grid = cg::this_grid();
    phase0(p, lds); grid.sync();
    for (int l = 0; l < 4; ++l) {
        phaseA(p, l, lds); grid.sync();
        phaseB(p, l, lds); grid.sync();
        phaseC(p, l, lds); grid.sync();
        phaseD(p, l, lds); grid.sync();
        phaseE1(p, l, lds); grid.sync();
        phaseE2(p, l, lds); grid.sync();
        phaseE3(p, l, lds); grid.sync();
        phaseF1(p, l, lds); grid.sync();
        phaseF2(p, l, lds); if (l < 3) grid.sync();
    }
}

extern "C" void kernel_launch(void* const* d_in, const int* in_sizes, int n_in, void* d_out, int out_size, void* d_ws, size_t ws_size, hipStream_t stream) {
    static int grid_blocks = 0;
    if (!grid_blocks) { int dev = 0, cus = 0, per_cu = 0; (void)hipGetDevice(&dev); (void)hipDeviceGetAttribute(&cus, hipDeviceAttributeMultiprocessorCount, dev);
        (void)hipOccupancyMaxActiveBlocksPerMultiprocessor(&per_cu, mega, 256, 0); if (per_cu > 2) per_cu = 2; grid_blocks = cus * per_cu; }
    if (ws_size < WS_NEED) { fprintf(stderr, "workspace too small: %zu < %zu\n", ws_size, (size_t)WS_NEED); return; }
    P p; memset(&p, 0, sizeof(p));
    const float** f = (const float**)&p.xp;
    for (int i = 0; i < 31; ++i) f[i] = (const float*)d_in[i];
    p.out = (float*)d_out; p.ws = (char*)d_ws;
    for (int i = 0; i < 32; ++i) p.inv32[i] = (float)pow(10000.0, -(double)i / 32.0);
    for (int i = 0; i < 16; ++i) p.inv16[i] = (float)pow(10000.0, -(double)i / 16.0);
    void* args[] = {(void*)&p};
    hipError_t e = hipLaunchCooperativeKernel((void*)mega, dim3(grid_blocks), dim3(256), args, 0, stream);
    if (e != hipSuccess) fprintf(stderr, "cooperative launch failed: %s (grid %d)\n", hipGetErrorString(e), grid_blocks);
}
```

```cpp
#include <hip/hip_runtime.h>
#include <hip/hip_cooperative_groups.h>
#include <cstdio>
#include <cmath>
#include <cstring>
namespace cg = cooperative_groups;

typedef unsigned short bf16_t;
typedef short bf16x8 __attribute__((ext_vector_type(8)));
typedef short s16x4 __attribute__((ext_vector_type(4)));
typedef float f32x16 __attribute__((ext_vector_type(16)));
typedef float f32x4 __attribute__((ext_vector_type(4)));
typedef float f32x2 __attribute__((ext_vector_type(2)));
typedef unsigned u32x4 __attribute__((ext_vector_type(4)));
typedef unsigned u32x2 __attribute__((ext_vector_type(2)));

#define MFMA32(a, b, c) __builtin_amdgcn_mfma_f32_32x32x16_bf16((a), (b), (c), 0, 0, 0)

constexpr int T = 32768;
constexpr int NPR = 16384;
constexpr float EPS = 1e-6f;
constexpr float LOG2E = 1.4426950408889634f;
constexpr int LDS_BYTES = 68096;
constexpr int LDS_SSB = 66560;
constexpr int LDS_SSX = 67072;

constexpr size_t SZ_WT_IN = (size_t)3968 * 1024 * 2, SZ_WT_UQ = (size_t)768 * 256 * 2, SZ_WT_UKV = (size_t)768 * 128 * 2,
                 SZ_WT_SQ = (size_t)1024 * 1024 * 2, SZ_WT_UP = (size_t)5632 * 1024 * 2, SZ_WT_DOWN = (size_t)1024 * 2816 * 2,
                 SZ_WT_CKV = (size_t)2048 * 1024 * 2;
constexpr size_t OFF_WT_IN = 0, OFF_WT_UQ = OFF_WT_IN + SZ_WT_IN, OFF_WT_UKV = OFF_WT_UQ + SZ_WT_UQ, OFF_WT_O = OFF_WT_UKV + SZ_WT_UKV,
                 OFF_WT_CQ = OFF_WT_O + SZ_WT_SQ, OFF_WT_CO = OFF_WT_CQ + SZ_WT_SQ, OFF_WT_UP = OFF_WT_CO + SZ_WT_SQ,
                 OFF_WT_DOWN = OFF_WT_UP + SZ_WT_UP, OFF_WT_CKV = OFF_WT_DOWN + SZ_WT_DOWN;
constexpr size_t OFF_MEMK = OFF_WT_CKV + SZ_WT_CKV;
constexpr size_t OFF_MEMVT = OFF_MEMK + (size_t)2560 * 1024 * 2;
constexpr size_t OFF_MEMSS = OFF_MEMVT + (size_t)2560 * 1024 * 2;
constexpr size_t OFF_ROPE32 = OFF_MEMSS + (size_t)2560 * 16 * 4;
constexpr size_t OFF_ROPE16 = OFF_ROPE32 + (size_t)8192 * 32 * 8;
constexpr size_t OFF_LSE = OFF_ROPE16 + (size_t)8192 * 16 * 8;
constexpr size_t OFF_MQ = OFF_LSE + (size_t)T * 12 * 4;
constexpr size_t OFF_MK = OFF_MQ + (size_t)T * 576 * 2;
constexpr size_t OFF_MVT = OFF_MK + (size_t)T * 576 * 2;
constexpr size_t OFF_Z = OFF_MVT + (size_t)384 * T * 2;
constexpr size_t OFF_ZC = OFF_Z;
constexpr size_t OFF_NAQ = OFF_ZC + (size_t)T * 416 * 2;
constexpr size_t OFF_NAK = OFF_NAQ + (size_t)T * 384 * 2;
constexpr size_t OFF_NAVT = OFF_NAK + (size_t)T * 384 * 2;
constexpr size_t OFF_DQ = OFF_NAVT + (size_t)T * 384 * 2;
constexpr size_t OFF_DK = OFF_DQ + (size_t)T * 768 * 2;
constexpr size_t OFF_DVT = OFF_DK + (size_t)T * 768 * 2;
constexpr size_t WS_NEED = OFF_DVT + (size_t)T * 768 * 2;
constexpr size_t OFF_XQ = OFF_Z;
constexpr size_t OFF_XO = OFF_XQ + (size_t)T * 1024 * 2;
constexpr size_t OFF_ACT = OFF_Z;

struct P {
    const float *xp, *xs, *memp, *mems;
    const float *norm_mix, *w_in, *mla_q_norm, *mla_kv_norm, *w_uq, *w_uk, *w_uv, *mla_qn, *mla_kn, *na_qn, *na_kn, *na_rpb, *dil_qn,
        *dil_kn, *w_o, *norm_cross, *norm_mem, *w_cq, *w_ckv, *x_qn, *x_kn, *w_co, *norm_ffn, *w_up, *conv_w, *conv_b, *w_down;
    float* out;
    char* ws;
    float inv32[32];
    float inv16[16];
};

__device__ __forceinline__ unsigned pk2(float lo, float hi) { unsigned r; asm("v_cvt_pk_bf16_f32 %0, %1, %2" : "=v"(r) : "v"(lo), "v"(hi)); return r; }
__device__ __forceinline__ float bflo(unsigned u) { return __uint_as_float(u << 16); }
__device__ __forceinline__ float bfhi(unsigned u) { return __uint_as_float(u & 0xffff0000u); }
__device__ __forceinline__ bf16_t f2bf(float f) { return (bf16_t)(pk2(f, f) & 0xffffu); }
__device__ __forceinline__ int otid() { int t = threadIdx.x; asm volatile("" : "+v"(t)); return t; }
__device__ __forceinline__ char* ows(char* w) { asm volatile("" : "+s"(w)); return w; }
__device__ __forceinline__ int crow(int r, int hh) { return (r & 3) + 8 * (r >> 2) + 4 * hh; }
__device__ __forceinline__ void tokinfo(int t, int& sbase, int& S) {
    if (t < NPR) { S = 2048; sbase = t & ~2047; } else { S = 8192; sbase = NPR + ((t - NPR) & ~8191); }
}
__device__ __forceinline__ int permtok(int t, int g) {
    int sbase, S; tokinfo(t, sbase, S); const int sh = 2 * g, pos = t - sbase;
    return sbase + (pos & ((1 << sh) - 1)) * (S >> sh) + (pos >> sh);
}

__device__ __forceinline__ bool swz(int it, int MT, int NT, int& mt, int& nt) {
    const int x = it & 7, j = it >> 3;
    const int m_lo = (MT * x) >> 3, m_hi = (MT * (x + 1)) >> 3, mc = m_hi - m_lo;
    if (j >= mc * NT) return false;
    const int grp = j / (8 * NT), rem = j - grp * 8 * NT;
    int gsz = mc - grp * 8; gsz = gsz > 8 ? 8 : gsz;
    nt = rem / gsz; mt = m_lo + grp * 8 + (rem - nt * gsz); return true;
}
__host__ __device__ constexpr int swz_count(int MT, int NT) { return 8 * ((MT + 7) / 8) * NT; }

struct CvtJob { const float* src; bf16_t* dst; const float* gain; int K, N, mode; };
__device__ __forceinline__ int rowmap(int mode, int n) {
    if (mode == 1) return n < 416 ? n : n + 96;
    if (mode == 2) return (n / 96) * 128 + (n % 96);
    if (mode == 3) { const int g = n >= 2816, f = g ? n - 2816 : n; return (f >> 6) * 128 + g * 64 + (f & 63); }
    return n;
}
__device__ __forceinline__ void cvt_tile(const CvtJob& j, int tile, char* lds) {
    const int tid = otid(), ntn = (j.N + 63) >> 6, tk = tile / ntn, tn = tile - tk * ntn, k0 = tk * 64, n0 = tn * 64;
    float* tl = (float*)lds;
    { const int tx = tid & 63, ty = tid >> 6, n = n0 + tx;
#pragma unroll
      for (int i = 0; i < 16; ++i) { const int k = k0 + ty * 16 + i; float v = (n < j.N) ? j.src[(size_t)k * j.N + n] : 0.f; if (j.gain) v *= j.gain[k]; tl[tx * 65 + ty * 16 + i] = v; } }
    __syncthreads();
    { const int rn = tid >> 2, c = tid & 3, n = n0 + rn;
      if (n < j.N) { const float* s = tl + rn * 65 + c * 16; bf16_t* d = j.dst + (size_t)rowmap(j.mode, n) * j.K + k0 + c * 16;
        u32x4 a = {pk2(s[0], s[1]), pk2(s[2], s[3]), pk2(s[4], s[5]), pk2(s[6], s[7])}, b = {pk2(s[8], s[9]), pk2(s[10], s[11]), pk2(s[12], s[13]), pk2(s[14], s[15])};
        *(u32x4*)d = a; *(u32x4*)(d + 8) = b; } }
    __syncthreads();
}
enum { W_IN = 0, W_UQ, W_UK, W_UV, W_O, W_CQ, W_CO, W_UP, W_DOWN, W_CKV, W_NUM };
__host__ __device__ constexpr int cvt_tiles(int w) {
    return w == W_IN ? 16 * 61 : w == W_UQ ? 4 * 9 : (w == W_UK || w == W_UV) ? 2 * 6 : (w == W_O || w == W_CQ || w == W_CO) ? 256 : w == W_UP ? 16 * 88 : w == W_DOWN ? 44 * 16 : 16 * 32;
}
__host__ __device__ constexpr int cvt_count(unsigned mask) { int n = 0; for (int w = 0; w < W_NUM; ++w) if (mask & (1u << w)) n += cvt_tiles(w); return n; }
__device__ __forceinline__ CvtJob get_cvt(const P& p, int l, int w) {
    CvtJob j; j.gain = nullptr; j.mode = 0;
    switch (w) {
    case W_IN: j.src = p.w_in + (size_t)l * 1024 * 3872; j.dst = (bf16_t*)(p.ws + OFF_WT_IN); j.gain = p.norm_mix + l * 1024; j.K = 1024; j.N = 3872; j.mode = 1; break;
    case W_UQ: j.src = p.w_uq + (size_t)l * 256 * 576; j.dst = (bf16_t*)(p.ws + OFF_WT_UQ); j.gain = p.mla_q_norm + l * 256; j.K = 256; j.N = 576; j.mode = 2; break;
    case W_UK: j.src = p.w_uk + (size_t)l * 128 * 384; j.dst = (bf16_t*)(p.ws + OFF_WT_UKV); j.gain = p.mla_kv_norm + l * 128; j.K = 128; j.N = 384; break;
    case W_UV: j.src = p.w_uv + (size_t)l * 128 * 384; j.dst = (bf16_t*)(p.ws + OFF_WT_UKV) + 384 * 128; j.gain = p.mla_kv_norm + l * 128; j.K = 128; j.N = 384; break;
    case W_O: j.src = p.w_o + (size_t)l * 1024 * 1024; j.dst = (bf16_t*)(p.ws + OFF_WT_O); j.K = 1024; j.N = 1024; break;
    case W_CQ: j.src = p.w_cq + (size_t)l * 1024 * 1024; j.dst = (bf16_t*)(p.ws + OFF_WT_CQ); j.gain = p.norm_cross + l * 1024; j.K = 1024; j.N = 1024; break;
    case W_CO: j.src = p.w_co + (size_t)l * 1024 * 1024; j.dst = (bf16_t*)(p.ws + OFF_WT_CO); j.K = 1024; j.N = 1024; break;
    case W_UP: j.src = p.w_up + (size_t)l * 1024 * 5632; j.dst = (bf16_t*)(p.ws + OFF_WT_UP); j.gain = p.norm_ffn + l * 1024; j.K = 1024; j.N = 5632; j.mode = 3; break;
    case W_DOWN: j.src = p.w_down + (size_t)l * 2816 * 1024; j.dst = (bf16_t*)(p.ws + OFF_WT_DOWN); j.K = 2816; j.N = 1024; break;
    default: j.src = p.w_ckv + (size_t)l * 1024 * 2048; j.dst = (bf16_t*)(p.ws + OFF_WT_CKV); j.gain = p.norm_mem + l * 1024; j.K = 1024; j.N = 2048; break;
    }
    return j;
}
__device__ __forceinline__ void cvt_item(const P& p, int l, unsigned mask, int it, char* lds) {
    for (int w = 0; w < W_NUM; ++w) if (mask & (1u << w)) { const int n = cvt_tiles(w); if (it < n) { CvtJob j = get_cvt(p, l, w); cvt_tile(j, it, lds); return; } it -= n; }
}

struct SrcX {
    static constexpr bool F32 = true, SS = true;
    const float *p0, *p1; int split;
    __device__ __forceinline__ const float* row(int t) const { return (t < split ? p0 : p1) + (size_t)t * 1024; }
    __device__ __forceinline__ const float* ptrf(int t, int k0) const { return row(t) + k0; }
    __device__ __forceinline__ const bf16_t* ptrb(int, int) const { return nullptr; }
};
template <bool SS_> struct SrcB {
    static constexpr bool F32 = false, SS = SS_;
    const bf16_t* p; int ld;
    __device__ __forceinline__ const float* ptrf(int, int) const { return nullptr; }
    __device__ __forceinline__ const bf16_t* ptrb(int t, int k0) const { return p + (size_t)t * ld + k0; }
};
struct SrcMix {
    static constexpr bool F32 = false, SS = false;
    const bf16_t *mq, *naq, *dq;
    __device__ __forceinline__ const float* ptrf(int, int) const { return nullptr; }
    __device__ __forceinline__ const bf16_t* ptrb(int t, int k0) const {
        if (k0 < 384) return mq + (size_t)t * 576 + (k0 >> 6) * 96 + (k0 & 63);
        if (k0 < 768) return naq + (size_t)t * 384 + (k0 - 384);
        return dq + (size_t)t * 768 + (k0 - 768);
    }
};
struct TileCtx { int f0, tok0, wm, wn, l31, hh; float rs[2]; };

template <class Src, class Epi>
__device__ __forceinline__ void gemm_tile(const Src src, const bf16_t* __restrict__ Wt, const int K, const int f0, const int tok0, const int vlo, const int vhi,
                                          const Epi epi, char* lds) {
    const int tid = otid(), lane = tid & 63, wid = tid >> 6, wm = wid >> 1, wn = wid & 1, l31 = lane & 31, hh = lane >> 5;
    const int lr = tid >> 1, lh = tid & 1;
    bf16_t* sW = (bf16_t*)lds; bf16_t* sA = sW + 2 * 5120; float* ssb = (float*)(lds + LDS_SSB);
    const int trow = tok0 + lr; const bool rv = trow >= vlo && trow < vhi;
    const bf16_t* wp = Wt + (size_t)(f0 + lr) * K + lh * 16;
    u32x4 wr0, wr1, ar0 = {0, 0, 0, 0}, ar1 = {0, 0, 0, 0}; f32x4 af0 = {0, 0, 0, 0}, af1 = af0, af2 = af0, af3 = af0; float ss = 0.f;
    f32x16 acc[2][2];
#pragma unroll
    for (int i = 0; i < 2; ++i)
#pragma unroll
        for (int j = 0; j < 2; ++j)
#pragma unroll
            for (int r = 0; r < 16; ++r) acc[i][j][r] = 0.f;
    const int nk = K >> 5;
#define GLOAD(k0_) do { wr0 = *(const u32x4*)(wp + (k0_)); wr1 = *(const u32x4*)(wp + (k0_) + 8);                                              \
        if (Src::F32) { if (rv) { const float* ap = src.ptrf(trow, (k0_)) + lh * 16; af0 = *(const f32x4*)ap; af1 = *(const f32x4*)(ap + 4);     \
                af2 = *(const f32x4*)(ap + 8); af3 = *(const f32x4*)(ap + 12); } }                                                             \
        else { if (rv) { const bf16_t* ap = src.ptrb(trow, (k0_)) + lh * 16; ar0 = *(const u32x4*)ap; ar1 = *(const u32x4*)(ap + 8); } } } while (0)
#define LSTORE(buf_) do {                                                                                                                       \
        if (Src::F32) { if (Src::SS) { ss += af0[0] * af0[0] + af0[1] * af0[1] + af0[2] * af0[2] + af0[3] * af0[3] + af1[0] * af1[0] + af1[1] * af1[1] + af1[2] * af1[2] + af1[3] * af1[3] \
                    + af2[0] * af2[0] + af2[1] * af2[1] + af2[2] * af2[2] + af2[3] * af2[3] + af3[0] * af3[0] + af3[1] * af3[1] + af3[2] * af3[2] + af3[3] * af3[3]; }   \
            ar0 = (u32x4){pk2(af0[0], af0[1]), pk2(af0[2], af0[3]), pk2(af1[0], af1[1]), pk2(af1[2], af1[3])};                                   \
            ar1 = (u32x4){pk2(af2[0], af2[1]), pk2(af2[2], af2[3]), pk2(af3[0], af3[1]), pk2(af3[2], af3[3])}; }                                 \
        else if (Src::SS) { _Pragma("unroll") for (int e_ = 0; e_ < 4; ++e_) { float a_ = bflo(ar0[e_]), b_ = bfhi(ar0[e_]), c_ = bflo(ar1[e_]), d_ = bfhi(ar1[e_]); \
                ss += a_ * a_ + b_ * b_ + c_ * c_ + d_ * d_; } }                                                                                \
        bf16_t* pw_ = sW + (buf_) * 5120 + lr * 40 + lh * 16; *(u32x4*)pw_ = wr0; *(u32x4*)(pw_ + 8) = wr1;                                      \
        bf16_t* pa_ = sA + (buf_) * 5120 + lr * 40 + lh * 16; *(u32x4*)pa_ = ar0; *(u32x4*)(pa_ + 8) = ar1; } while (0)
    GLOAD(0);
    LSTORE(0);
    __syncthreads();
    for (int kt = 0; kt < nk; ++kt) {
        if (kt + 1 < nk) GLOAD((kt + 1) * 32);
        { const int buf = kt & 1;
          const bf16_t* bw = sW + buf * 5120 + (wm * 64 + l31) * 40 + hh * 8;
          const bf16_t* ba = sA + buf * 5120 + (wn * 64 + l31) * 40 + hh * 8;
#pragma unroll
          for (int ks = 0; ks < 2; ++ks) {
              const bf16x8 a0 = *(const bf16x8*)(bw + ks * 16), a1 = *(const bf16x8*)(bw + 32 * 40 + ks * 16);
              const bf16x8 b0 = *(const bf16x8*)(ba + ks * 16), b1 = *(const bf16x8*)(ba + 32 * 40 + ks * 16);
              acc[0][0] = MFMA32(a0, b0, acc[0][0]); acc[0][1] = MFMA32(a0, b1, acc[0][1]);
              acc[1][0] = MFMA32(a1, b0, acc[1][0]); acc[1][1] = MFMA32(a1, b1, acc[1][1]);
          } }
        if (kt + 1 < nk) LSTORE((kt + 1) & 1);
        __syncthreads();
    }
#undef GLOAD
#undef LSTORE
    TileCtx c; c.f0 = f0; c.tok0 = tok0; c.wm = wm; c.wn = wn; c.l31 = l31; c.hh = hh; c.rs[0] = 1.f; c.rs[1] = 1.f;
    if (Src::SS) {
        ss += __shfl_xor(ss, 1);
        if (lh == 0) ssb[lr] = ss;
        __syncthreads();
        const float invk = 1.0f / (float)K;
        c.rs[0] = rsqrtf(ssb[wn * 64 + l31] * invk + EPS); c.rs[1] = rsqrtf(ssb[wn * 64 + 32 + l31] * invk + EPS);
    }
    epi(acc, c, lds);
}

__device__ __forceinline__ void st4(bf16_t* p, float a, float b, float c, float d) { u32x2 w = {pk2(a, b), pk2(c, d)}; *(u32x2*)p = w; }

struct EpiIn {
    bf16_t *zc, *naq, *nak, *navT, *dq, *dk, *dvT; const float *na_qn, *na_kn, *dil_qn, *dil_kn; const f32x2* rope32;
    __device__ __forceinline__ void operator()(f32x16 (&acc)[2][2], const TileCtx& c, char*) const {
        const int fw = c.f0 + c.wm * 64;
        if (fw < 512) {
#pragma unroll
            for (int mt = 0; mt < 2; ++mt) { const int fb = fw + mt * 32; if (fb >= 416) continue;
#pragma unroll
                for (int nt = 0; nt < 2; ++nt) { const int t = c.tok0 + c.wn * 64 + nt * 32 + c.l31; const float rs = c.rs[nt];
#pragma unroll
                    for (int g = 0; g < 4; ++g) st4(zc + (size_t)t * 416 + fb + 8 * g + 4 * c.hh, acc[mt][nt][4 * g] * rs, acc[mt][nt][4 * g + 1] * rs, acc[mt][nt][4 * g + 2] * rs, acc[mt][nt][4 * g + 3] * rs); } }
        } else if (fw < 1664) {
            const int pf = fw - 512, which = pf / 384, head = (pf - which * 384) >> 6;
            if (which < 2) { const float* gain = which ? na_kn : na_qn; bf16_t* dst = which ? nak : naq;
#pragma unroll
                for (int nt = 0; nt < 2; ++nt) { const int t = c.tok0 + c.wn * 64 + nt * 32 + c.l31; const float rs = c.rs[nt]; float ss = 0.f;
#pragma unroll
                    for (int mt = 0; mt < 2; ++mt)
#pragma unroll
                        for (int r = 0; r < 16; ++r) { const float v = acc[mt][nt][r] * rs; acc[mt][nt][r] = v; ss += v * v; }
                    ss += __shfl_xor(ss, 32); const float rq = rsqrtf(ss * (1.f / 64.f) + EPS);
#pragma unroll
                    for (int mt = 0; mt < 2; ++mt)
#pragma unroll
                        for (int g = 0; g < 4; ++g) { const int d = mt * 32 + 8 * g + 4 * c.hh; const f32x4 gn = *(const f32x4*)(gain + d);
                            st4(dst + (size_t)t * 384 + head * 64 + d, acc[mt][nt][4 * g] * rq * gn[0], acc[mt][nt][4 * g + 1] * rq * gn[1], acc[mt][nt][4 * g + 2] * rq * gn[2], acc[mt][nt][4 * g + 3] * rq * gn[3]); } }
            } else {
#pragma unroll
                for (int nt = 0; nt < 2; ++nt) { const int t = c.tok0 + c.wn * 64 + nt * 32 + c.l31; const float rs = c.rs[nt];
#pragma unroll
                    for (int mt = 0; mt < 2; ++mt)
#pragma unroll
                        for (int r = 0; r < 16; ++r) navT[(size_t)(head * 64 + mt * 32 + crow(r, c.hh)) * T + t] = f2bf(acc[mt][nt][r] * rs); }
            }
        } else {
            const int pf = fw - 1664, which = pf / 768, h12 = (pf - which * 768) >> 6, g4 = h12 >> 2;
#pragma unroll
            for (int nt = 0; nt < 2; ++nt) { const int t = c.tok0 + c.wn * 64 + nt * 32 + c.l31; const float rs = c.rs[nt];
                int sbase, S; tokinfo(t, sbase, S); const int pos = t - sbase, sh = 2 * g4; const int tp = sbase + (pos & ((1 << sh) - 1)) * (S >> sh) + (pos >> sh);
                if (which < 2) { const float* gain = which ? dil_kn : dil_qn; bf16_t* dst = which ? dk : dq; float ss = 0.f;
#pragma unroll
                    for (int mt = 0; mt < 2; ++mt)
#pragma unroll
                        for (int r = 0; r < 16; ++r) { const float v = acc[mt][nt][r] * rs; acc[mt][nt][r] = v; ss += v * v; }
                    ss += __shfl_xor(ss, 32); const float rq = rsqrtf(ss * (1.f / 64.f) + EPS);
#pragma unroll
                    for (int g = 0; g < 4; ++g) { const int d = 8 * g + 4 * c.hh; const f32x4 g1 = *(const f32x4*)(gain + d), g2 = *(const f32x4*)(gain + 32 + d);
                        const f32x4 cs0 = *(const f32x4*)(rope32 + pos * 32 + d), cs1 = *(const f32x4*)(rope32 + pos * 32 + d + 2);
                        float o1[4], o2[4];
#pragma unroll
                        for (int j = 0; j < 4; ++j) { const float x1 = acc[0][nt][4 * g + j] * rq * g1[j], x2 = acc[1][nt][4 * g + j] * rq * g2[j];
                            const float cc = j < 2 ? cs0[2 * j] : cs1[2 * (j - 2)], sn = j < 2 ? cs0[2 * j + 1] : cs1[2 * (j - 2) + 1];
                            o1[j] = x1 * cc - x2 * sn; o2[j] = x2 * cc + x1 * sn; }
                        st4(dst + (size_t)tp * 768 + h12 * 64 + d, o1[0], o1[1], o1[2], o1[3]); st4(dst + (size_t)tp * 768 + h12 * 64 + 32 + d, o2[0], o2[1], o2[2], o2[3]); }
                } else {
#pragma unroll
                    for (int mt = 0; mt < 2; ++mt)
#pragma unroll
                        for (int r = 0; r < 16; ++r) dvT[(size_t)(h12 * 64 + mt * 32 + crow(r, c.hh)) * T + tp] = f2bf(acc[mt][nt][r] * rs);
                } }
        }
    }
};

struct EpiUq {
    bf16_t* mq; const float* qn; const f32x2* rope16;
    __device__ __forceinline__ void operator()(f32x16 (&acc)[2][2], const TileCtx& c, char* lds) const {
        float* ssx = (float*)(lds + LDS_SSX); const int head = c.f0 >> 7;
#pragma unroll
        for (int nt = 0; nt < 2; ++nt) { float ss = 0.f;
#pragma unroll
            for (int mt = 0; mt < 2; ++mt) { if (c.wm == 1 && mt == 1) continue;
#pragma unroll
                for (int r = 0; r < 16; ++r) { const float v = acc[mt][nt][r] * c.rs[nt]; acc[mt][nt][r] = v; ss += v * v; } }
            ss += __shfl_xor(ss, 32); if (c.hh == 0) ssx[c.wm * 128 + c.wn * 64 + nt * 32 + c.l31] = ss; }
        __syncthreads();
#pragma unroll
        for (int nt = 0; nt < 2; ++nt) { const int tl = c.wn * 64 + nt * 32 + c.l31, t = c.tok0 + tl; const float rq = rsqrtf((ssx[tl] + ssx[128 + tl]) * (1.f / 96.f) + EPS);
            int sbase, S; tokinfo(t, sbase, S); const int pos = t - sbase; bf16_t* dst = mq + (size_t)t * 576 + head * 96 + c.wm * 64;
            if (c.wm == 0) {
#pragma unroll
                for (int mt = 0; mt < 2; ++mt)
#pragma unroll
                    for (int g = 0; g < 4; ++g) { const int d = mt * 32 + 8 * g + 4 * c.hh; const f32x4 gn = *(const f32x4*)(qn + d);
                        st4(dst + d, acc[mt][nt][4 * g] * rq * gn[0], acc[mt][nt][4 * g + 1] * rq * gn[1], acc[mt][nt][4 * g + 2] * rq * gn[2], acc[mt][nt][4 * g + 3] * rq * gn[3]); }
            } else {
#pragma unroll
                for (int g = 0; g < 2; ++g) { const int i = 8 * g + 4 * c.hh; const f32x4 g1 = *(const f32x4*)(qn + 64 + i), g2 = *(const f32x4*)(qn + 80 + i);
                    const f32x4 cs0 = *(const f32x4*)(rope16 + pos * 16 + i), cs1 = *(const f32x4*)(rope16 + pos * 16 + i + 2); float o1[4], o2[4];
#pragma unroll
                    for (int j = 0; j < 4; ++j) { const float x1 = acc[0][nt][4 * g + j] * rq * g1[j], x2 = acc[0][nt][8 + 4 * g + j] * rq * g2[j];
                        const float cc = j < 2 ? cs0[2 * j] : cs1[2 * (j - 2)], sn = j < 2 ? cs0[2 * j + 1] : cs1[2 * (j - 2) + 1];
                        o1[j] = x1 * cc - x2 * sn; o2[j] = x2 * cc + x1 * sn; }
                    st4(dst + i, o1[0], o1[1], o1[2], o1[3]); st4(dst + 16 + i, o2[0], o2[1], o2[2], o2[3]); }
            } }
    }
};

struct EpiUkv {
    bf16_t *mk, *mvT; const bf16_t* zc; const float* kn; const f32x2* rope16;
    __device__ __forceinline__ void operator()(f32x16 (&acc)[2][2], const TileCtx& c, char*) const {
        const int fw = c.f0 + c.wm * 64;
        if (fw < 384) { const int head = fw >> 6;
#pragma unroll
            for (int nt = 0; nt < 2; ++nt) { const int t = c.tok0 + c.wn * 64 + nt * 32 + c.l31; const float rs = c.rs[nt]; float ss = 0.f;
#pragma unroll
                for (int mt = 0; mt < 2; ++mt)
#pragma unroll
                    for (int r = 0; r < 16; ++r) { const float v = acc[mt][nt][r] * rs; acc[mt][nt][r] = v; ss += v * v; }
                const bf16_t* krp = zc + (size_t)t * 416 + 384 + 8 * c.hh; const u32x4 ka = *(const u32x4*)krp, kb = *(const u32x4*)(krp + 16);
                float x1[8], x2[8];
#pragma unroll
                for (int e = 0; e < 4; ++e) { x1[2 * e] = bflo(ka[e]); x1[2 * e + 1] = bfhi(ka[e]); x2[2 * e] = bflo(kb[e]); x2[2 * e + 1] = bfhi(kb[e]); }
#pragma unroll
                for (int e = 0; e < 8; ++e) ss += x1[e] * x1[e] + x2[e] * x2[e];
                ss += __shfl_xor(ss, 32); const float rq = rsqrtf(ss * (1.f / 96.f) + EPS);
                int sbase, S; tokinfo(t, sbase, S); const int pos = t - sbase; bf16_t* dst = mk + (size_t)t * 576 + head * 96;
#pragma unroll
                for (int mt = 0; mt < 2; ++mt)
#pragma unroll
                    for (int g = 0; g < 4; ++g) { const int d = mt * 32 + 8 * g + 4 * c.hh; const f32x4 gn = *(const f32x4*)(kn + d);
                        st4(dst + d, acc[mt][nt][4 * g] * rq * gn[0], acc[mt][nt][4 * g + 1] * rq * gn[1], acc[mt][nt][4 * g + 2] * rq * gn[2], acc[mt][nt][4 * g + 3] * rq * gn[3]); }
                float o1[8], o2[8];
#pragma unroll
                for (int e = 0; e < 8; ++e) { const int i = 8 * c.hh + e; const f32x2 cs = rope16[pos * 16 + i]; const float a = x1[e] * rq * kn[64 + i], b = x2[e] * rq * kn[80 + i];
                    o1[e] = a * cs[0] - b * cs[1]; o2[e] = b * cs[0] + a * cs[1]; }
                u32x4 w1 = {pk2(o1[0], o1[1]), pk2(o1[2], o1[3]), pk2(o1[4], o1[5]), pk2(o1[6], o1[7])}, w2 = {pk2(o2[0], o2[1]), pk2(o2[2], o2[3]), pk2(o2[4], o2[5]), pk2(o2[6], o2[7])};
                *(u32x4*)(dst + 64 + 8 * c.hh) = w1; *(u32x4*)(dst + 80 + 8 * c.hh) = w2; }
        } else { const int head = (fw - 384) >> 6;
#pragma unroll
            for (int nt = 0; nt < 2; ++nt) { const int t = c.tok0 + c.wn * 64 + nt * 32 + c.l31; const float rs = c.rs[nt];
#pragma unroll
                for (int mt = 0; mt < 2; ++mt)
#pragma unroll
                    for (int r = 0; r < 16; ++r) mvT[(size_t)(head * 64 + mt * 32 + crow(r, c.hh)) * T + t] = f2bf(acc[mt][nt][r] * rs); }
        }
    }
};

struct EpiRes {
    SrcX xin; float* out;
    __device__ __forceinline__ void operator()(f32x16 (&acc)[2][2], const TileCtx& c, char*) const {
#pragma unroll
        for (int nt = 0; nt < 2; ++nt) { const int t = c.tok0 + c.wn * 64 + nt * 32 + c.l31; const float* xr = xin.row(t); float* orow = out + (size_t)t * 1024;
#pragma unroll
            for (int mt = 0; mt < 2; ++mt)
#pragma unroll
                for (int g = 0; g < 4; ++g) { const int f = c.f0 + c.wm * 64 + mt * 32 + 8 * g + 4 * c.hh; f32x4 v = *(const f32x4*)(xr + f);
                    v[0] += acc[mt][nt][4 * g]; v[1] += acc[mt][nt][4 * g + 1]; v[2] += acc[mt][nt][4 * g + 2]; v[3] += acc[mt][nt][4 * g + 3]; *(f32x4*)(orow + f) = v; } }
    }
};

struct EpiBf {
    bf16_t* dst; int ld;
    __device__ __forceinline__ void operator()(f32x16 (&acc)[2][2], const TileCtx& c, char*) const {
#pragma unroll
        for (int nt = 0; nt < 2; ++nt) { const int t = c.tok0 + c.wn * 64 + nt * 32 + c.l31; const float rs = c.rs[nt];
#pragma unroll
            for (int mt = 0; mt < 2; ++mt)
#pragma unroll
                for (int g = 0; g < 4; ++g) { const int f = c.f0 + c.wm * 64 + mt * 32 + 8 * g + 4 * c.hh;
                    st4(dst + (size_t)t * ld + f, acc[mt][nt][4 * g] * rs, acc[mt][nt][4 * g + 1] * rs, acc[mt][nt][4 * g + 2] * rs, acc[mt][nt][4 * g + 3] * rs); } }
    }
};

struct EpiMem {
    bf16_t *memK, *memVT; float* memss; const float *xkn, *xqn;
    __device__ __forceinline__ void operator()(f32x16 (&acc)[2][2], const TileCtx& c, char*) const {
        const int fw = c.f0 + c.wm * 64;
#pragma unroll
        for (int nt = 0; nt < 2; ++nt) { const int m = c.tok0 + c.wn * 64 + nt * 32 + c.l31; const float rs = c.rs[nt];
            if (fw < 1024) { float ss = 0.f;
#pragma unroll
                for (int mt = 0; mt < 2; ++mt)
#pragma unroll
                    for (int r = 0; r < 16; ++r) { const float v = acc[mt][nt][r] * rs; acc[mt][nt][r] = v; ss += v * v; }
                ss += __shfl_xor(ss, 32); if (c.hh == 0) memss[m * 16 + (fw >> 6)] = ss;
#pragma unroll
                for (int mt = 0; mt < 2; ++mt)
#pragma unroll
                    for (int g = 0; g < 4; ++g) { const int f = fw + mt * 32 + 8 * g + 4 * c.hh, d = f & 255; const f32x4 gk = *(const f32x4*)(xkn + d), gq = *(const f32x4*)(xqn + d);
                        st4(memK + (size_t)m * 1024 + f, acc[mt][nt][4 * g] * gk[0] * gq[0] * 0.0625f, acc[mt][nt][4 * g + 1] * gk[1] * gq[1] * 0.0625f,
                            acc[mt][nt][4 * g + 2] * gk[2] * gq[2] * 0.0625f, acc[mt][nt][4 * g + 3] * gk[3] * gq[3] * 0.0625f); }
            } else { const int b = m >> 8, key = m & 255;
#pragma unroll
                for (int mt = 0; mt < 2; ++mt)
#pragma unroll
                    for (int r = 0; r < 16; ++r) memVT[((size_t)(b * 1024 + fw - 1024 + mt * 32 + crow(r, c.hh)) << 8) + key] = f2bf(acc[mt][nt][r] * rs);
            } }
    }
};

struct EpiFfn {
    bf16_t* act; const float *cw, *cb; int sbase, S, pos0, ft;
    __device__ __forceinline__ void operator()(f32x16 (&acc)[2][2], const TileCtx& c, char* lds) const {
        float* U = (float*)lds;
#pragma unroll
        for (int nt = 0; nt < 2; ++nt) { const int tl = c.wn * 64 + nt * 32 + c.l31; const float rs = c.rs[nt];
#pragma unroll
            for (int mt = 0; mt < 2; ++mt)
#pragma unroll
                for (int r = 0; r < 16; ++r) U[tl * 129 + c.wm * 64 + mt * 32 + crow(r, c.hh)] = acc[mt][nt][r] * rs; }
        __syncthreads();
        { const int tid = otid(), f = tid & 63, tq = tid >> 6, fa = ft * 64 + f, fg = 2816 + fa;
          const float a0 = cw[fa], a1 = cw[5632 + fa], a2 = cw[2 * 5632 + fa], ab = cb[fa], g0 = cw[fg], g1 = cw[5632 + fg], g2 = cw[2 * 5632 + fg], gb = cb[fg];
          const int i0 = 1 + tq * 32; int i1 = i0 + 32; if (i1 > 127) i1 = 127;
          float pa = U[(i0 - 1) * 129 + f], ca = U[i0 * 129 + f], pg = U[(i0 - 1) * 129 + 64 + f], cg_ = U[i0 * 129 + 64 + f];
          for (int i = i0; i < i1; ++i) { const float na = U[(i + 1) * 129 + f], ng = U[(i + 1) * 129 + 64 + f];
              const float ua = a0 * pa + a1 * ca + a2 * na + ab, ug = g0 * pg + g1 * cg_ + g2 * ng + gb;
              const float y = ua * ug / (1.f + __expf(-ug)); const int pos = pos0 + i;
              if (pos < S) act[(size_t)(sbase + pos) * 2816 + fa] = f2bf(y);
              pa = ca; ca = na; pg = cg_; cg_ = ng; } }
        __syncthreads();
    }
};

template <int NKS, int NDT, class Hook>
__device__ __forceinline__ void attn_wave(const bf16_t* __restrict__ qrow, const bf16_t* __restrict__ kb, const int kstride, const bf16_t* __restrict__ vT, const size_t vstride,
                                          const int sub_lo, const int sub_hi, Hook& hook, f32x16 (&O)[NDT], float& m_out, float& l_out) {
    const int lane = otid() & 63, l31 = lane & 31, hh = lane >> 5;
    bf16x8 qf[NKS];
#pragma unroll
    for (int ks = 0; ks < NKS; ++ks) qf[ks] = *(const bf16x8*)(qrow + ks * 16 + hh * 8);
    hook.init(qf);
    float m = -1e30f, lsum = 0.f;
#pragma unroll
    for (int dt = 0; dt < NDT; ++dt)
#pragma unroll
        for (int r = 0; r < 16; ++r) O[dt][r] = 0.f;
    for (int sub = sub_lo; sub < sub_hi; ++sub) {
        const bf16_t* kp = kb + (size_t)(sub * 32 + l31) * kstride + hh * 8;
        f32x16 s;
#pragma unroll
        for (int r = 0; r < 16; ++r) s[r] = 0.f;
#pragma unroll
        for (int ks = 0; ks < NKS; ++ks) s = MFMA32(*(const bf16x8*)(kp + ks * 16), qf[ks], s);
        hook.apply(s, sub);
        float mx = s[0];
#pragma unroll
        for (int r = 1; r < 16; ++r) mx = fmaxf(mx, s[r]);
        mx = fmaxf(mx, __shfl_xor(mx, 32));
        const float mn = fmaxf(m, mx), alpha = __builtin_amdgcn_exp2f(m - mn); m = mn;
        float ps = 0.f;
#pragma unroll
        for (int r = 0; r < 16; ++r) { s[r] = __builtin_amdgcn_exp2f(s[r] - mn); ps += s[r]; }
        lsum = lsum * alpha + ps;
        u32x4 w0 = {pk2(s[0], s[1]), pk2(s[2], s[3]), pk2(s[4], s[5]), pk2(s[6], s[7])}, w1 = {pk2(s[8], s[9]), pk2(s[10], s[11]), pk2(s[12], s[13]), pk2(s[14], s[15])};
        const bf16x8 pf0 = *(bf16x8*)&w0, pf1 = *(bf16x8*)&w1;
#pragma unroll
        for (int dt = 0; dt < NDT; ++dt) {
            const bf16_t* vp = vT + (size_t)(dt * 32 + l31) * vstride + sub * 32 + hh * 4;
            const s16x4 a0 = *(const s16x4*)vp, a1 = *(const s16x4*)(vp + 8), b0 = *(const s16x4*)(vp + 16), b1 = *(const s16x4*)(vp + 24);
#pragma unroll
            for (int r = 0; r < 16; ++r) O[dt][r] *= alpha;
            const bf16x8 va = {a0[0], a0[1], a0[2], a0[3], a1[0], a1[1], a1[2], a1[3]}, vb = {b0[0], b0[1], b0[2], b0[3], b1[0], b1[1], b1[2], b1[3]};
            O[dt] = MFMA32(va, pf0, O[dt]); O[dt] = MFMA32(vb, pf1, O[dt]);
        }
    }
    l_out = lsum + __shfl_xor(lsum, 32); m_out = m;
}
template <int NDT>
__device__ __forceinline__ void attn_store(bf16_t* orow, const f32x16 (&O)[NDT], float l) {
    const int hh = (otid() & 63) >> 5; const float inv = 1.f / l;
#pragma unroll
    for (int dt = 0; dt < NDT; ++dt)
#pragma unroll
        for (int g = 0; g < 4; ++g) st4(orow + dt * 32 + 8 * g + 4 * hh, O[dt][4 * g] * inv, O[dt][4 * g + 1] * inv, O[dt][4 * g + 2] * inv, O[dt][4 * g + 3] * inv);
}

struct HookDense { float sc;
    template <class Q> __device__ __forceinline__ void init(Q&) {}
    __device__ __forceinline__ void apply(f32x16& s, int) const {
#pragma unroll
        for (int r = 0; r < 16; ++r) s[r] *= sc; } };
struct HookNA { const float* rpb; int c, cs, joff, hh;
    template <class Q> __device__ __forceinline__ void init(Q&) {}
    __device__ __forceinline__ void apply(f32x16& s, int sub) const { const int j = sub >> 1, cb = (sub & 1) * 32; const float* row = rpb + (joff + j) * 31 + 15 - c;
#pragma unroll
        for (int r = 0; r < 16; ++r) { const int col = cb + crow(r, hh); const bool v = (unsigned)(col - cs) < 16u; const float b = v ? row[col] : 0.f;
            s[r] = v ? (s[r] * 0.125f + b) * LOG2E : -1e30f; } } };
struct HookDil { int qv, hh;
    template <class Q> __device__ __forceinline__ void init(Q&) {}
    __device__ __forceinline__ void apply(f32x16& s, int sub) const {
#pragma unroll
        for (int r = 0; r < 16; ++r) { int d = sub * 32 + crow(r, hh) - qv; d = d < 0 ? -d : d; s[r] = d <= 64 ? s[r] * (0.125f * LOG2E) : -1e30f; } } };
struct HookX { const float* ss; int hh; float rq;
    template <class Q> __device__ __forceinline__ void init(Q& qf) { float a = 0.f;
#pragma unroll
        for (int ks = 0; ks < 16; ++ks)
#pragma unroll
            for (int e = 0; e < 8; ++e) { const float v = __uint_as_float(((unsigned)(unsigned short)qf[ks][e]) << 16); a += v * v; }
        a += __shfl_xor(a, 32); rq = rsqrtf(a * (1.f / 256.f) + EPS) * LOG2E; }
    __device__ __forceinline__ void apply(f32x16& s, int sub) const {
#pragma unroll
        for (int r = 0; r < 16; ++r) { const f32x4 q = *(const f32x4*)(ss + (sub * 32 + crow(r, hh)) * 16); const float rk = rsqrtf((q[0] + q[1] + q[2] + q[3]) * (1.f / 256.f) + EPS);
            s[r] *= rq * rk; } } };

__device__ __forceinline__ SrcX xsrc(const P& p, int l, bool after_mix) {
    SrcX s; if (l == 0 && !after_mix) { s.p0 = p.xp; s.p1 = p.xs - (size_t)NPR * 1024; s.split = NPR; } else { s.p0 = p.out; s.p1 = p.out; s.split = T; } return s;
}

__device__ void phase0(const P& p, char* lds) {
    constexpr unsigned mask = (1u << W_NUM) - 1;
    const int ncv = cvt_count(mask), nrope = 8192 * 48 / 256;
    for (int it = blockIdx.x; it < ncv + nrope; it += gridDim.x) {
        if (it < ncv) cvt_item(p, 0, mask, it, lds);
        else { const int idx = (it - ncv) * 256 + otid(); int pos, i; float inv; f32x2* dst;
            if (idx < 8192 * 32) { pos = idx >> 5; i = idx & 31; inv = p.inv32[i]; dst = (f32x2*)(p.ws + OFF_ROPE32) + idx; }
            else { const int k = idx - 8192 * 32; pos = k >> 4; i = k & 15; inv = p.inv16[i]; dst = (f32x2*)(p.ws + OFF_ROPE16) + k; }
            const float ang = (float)pos * inv; const double tr = (double)ang * 0.15915494309189535; const float fr = (float)(tr - rint(tr));
            f32x2 cs = {__builtin_amdgcn_cosf(fr), __builtin_amdgcn_sinf(fr)}; *dst = cs; }
    }
}

__device__ void phaseA(const P& p, int l, char* lds) {
    const unsigned mask = l > 0 ? (1u << W_DOWN) : 0u; const int ncv = (cvt_count(mask) + 7) & ~7;
    const int nmem = swz_count(20, 16), nin = swz_count(256, 31);
    char* ws = ows(p.ws);
    for (int it = blockIdx.x; it < ncv + nmem + nin; it += gridDim.x) {
        if (it < ncv) { if (it < cvt_count(mask)) cvt_item(p, l, mask, it, lds); }
        else if (it < ncv + nmem) { int mt, nt; if (!swz(it - ncv, 20, 16, mt, nt)) continue;
            SrcX s; s.p0 = p.memp; s.p1 = p.mems - (size_t)2048 * 1024; s.split = 2048;
            EpiMem e; e.memK = (bf16_t*)(ws + OFF_MEMK); e.memVT = (bf16_t*)(ws + OFF_MEMVT); e.memss = (float*)(ws + OFF_MEMSS); e.xkn = p.x_kn + l * 256; e.xqn = p.x_qn + l * 256;
            gemm_tile(s, (const bf16_t*)(ws + OFF_WT_CKV), 1024, nt * 128, mt * 128, 0, 2560, e, lds); }
        else { int mt, nt; if (!swz(it - ncv - nmem, 256, 31, mt, nt)) continue;
            EpiIn e; e.zc = (bf16_t*)(ws + OFF_ZC); e.naq = (bf16_t*)(ws + OFF_NAQ); e.nak = (bf16_t*)(ws + OFF_NAK); e.navT = (bf16_t*)(ws + OFF_NAVT);
            e.dq = (bf16_t*)(ws + OFF_DQ); e.dk = (bf16_t*)(ws + OFF_DK); e.dvT = (bf16_t*)(ws + OFF_DVT);
            e.na_qn = p.na_qn + l * 64; e.na_kn = p.na_kn + l * 64; e.dil_qn = p.dil_qn + l * 64; e.dil_kn = p.dil_kn + l * 64; e.rope32 = (const f32x2*)(ws + OFF_ROPE32);
            gemm_tile(xsrc(p, l, false), (const bf16_t*)(ws + OFF_WT_IN), 1024, nt * 128, mt * 128, 0, T, e, lds); }
    }
}

__device__ void phaseB(const P& p, int l, char* lds) {
    char* ws = ows(p.ws); const int nuq = swz_count(256, 6), nukv = swz_count(256, 6), nna = 512 * 3, ndil = 12 * 256;
    const int tid_ = otid(), wid = tid_ >> 6, lane = tid_ & 63, l31 = lane & 31, hh = lane >> 5;
    for (int it = blockIdx.x; it < nuq + nukv + nna + ndil; it += gridDim.x) {
        if (it < nuq) { int mt, nt; if (!swz(it, 256, 6, mt, nt)) continue;
            SrcB<true> s; s.p = (const bf16_t*)(ws + OFF_ZC); s.ld = 416;
            EpiUq e; e.mq = (bf16_t*)(ws + OFF_MQ); e.qn = p.mla_qn + l * 96; e.rope16 = (const f32x2*)(ws + OFF_ROPE16);
            gemm_tile(s, (const bf16_t*)(ws + OFF_WT_UQ), 256, nt * 128, mt * 128, 0, T, e, lds); }
        else if (it < nuq + nukv) { int mt, nt; if (!swz(it - nuq, 256, 6, mt, nt)) continue;
            SrcB<true> s; s.p = (const bf16_t*)(ws + OFF_ZC) + 256; s.ld = 416;
            EpiUkv e; e.mk = (bf16_t*)(ws + OFF_MK); e.mvT = (bf16_t*)(ws + OFF_MVT); e.zc = (const bf16_t*)(ws + OFF_ZC); e.kn = p.mla_kn + l * 96; e.rope16 = (const f32x2*)(ws + OFF_ROPE16);
            gemm_tile(s, (const bf16_t*)(ws + OFF_WT_UKV), 128, nt * 128, mt * 128, 0, T, e, lds); }
        else if (it < nuq + nukv + nna) { const int bi = it - nuq - nukv, R = bi / 3, hp = bi - R * 3, head = hp * 2 + (wid >> 1), ch = wid & 1;
            const int tR = R * 64; int sbase, S; tokinfo(tR, sbase, S); const int r = (tR - sbase) >> 6, rows = S >> 6;
            int rs = r - 4; rs = rs < 0 ? 0 : rs; rs = rs > rows - 8 ? rows - 8 : rs; const int kbase = sbase + rs * 64;
            bf16_t* naq = (bf16_t*)(ws + OFF_NAQ); bf16_t* qrow = naq + (size_t)(tR + ch * 32 + l31) * 384 + head * 64;
            HookNA hk; hk.rpb = p.na_rpb + ((size_t)l * 6 + head) * 465; hk.c = ch * 32 + l31; int cs = hk.c - 8; cs = cs < 0 ? 0 : cs; cs = cs > 48 ? 48 : cs; hk.cs = cs; hk.joff = rs - r + 7; hk.hh = hh;
            f32x16 O[2]; float m, lsum;
            attn_wave<4, 2>(qrow, (const bf16_t*)(ws + OFF_NAK) + (size_t)kbase * 384 + head * 64, 384, (const bf16_t*)(ws + OFF_NAVT) + (size_t)(head * 64) * T + kbase, (size_t)T, 0, 16, hk, O, m, lsum);
            attn_store<2>(qrow, O, lsum); }
        else { const int bi = it - nuq - nukv - nna, h12 = bi >> 8, qi = (bi & 255) * 4 + wid, g = h12 >> 2, tp0 = qi * 32;
            int sbase, S; tokinfo(tp0, sbase, S); const int L = S >> (2 * g), off = tp0 - sbase, rho = off / L, i0 = off - rho * L, vsb = sbase + rho * L;
            int slo = (i0 - 64) >> 5; slo = slo < 0 ? 0 : slo; int shi = (i0 + 96) >> 5; shi = shi > (L >> 5) ? (L >> 5) : shi;
            bf16_t* dq = (bf16_t*)(ws + OFF_DQ); bf16_t* qrow = dq + (size_t)(tp0 + l31) * 768 + h12 * 64;
            HookDil hk; hk.qv = i0 + l31; hk.hh = hh; f32x16 O[2]; float m, lsum;
            attn_wave<4, 2>(qrow, (const bf16_t*)(ws + OFF_DK) + (size_t)vsb * 768 + h12 * 64, 768, (const bf16_t*)(ws + OFF_DVT) + (size_t)(h12 * 64) * T + vsb, (size_t)T, slo, shi, hk, O, m, lsum);
            attn_store<2>(qrow, O, lsum);
            if (hh == 0) { const int tn = sbase + ((i0 + l31) << (2 * g)) + rho; ((float*)(ws + OFF_LSE))[(size_t)tn * 12 + h12] = (m + __log2f(lsum)) * 0.6931471805599453f; } }
    }
}

__device__ void phaseC(const P& p, int l, char* lds) {
    char* ws = ows(p.ws); const unsigned mask = l < 3 ? ((1u << W_IN) | (1u << W_UQ) | (1u << W_UK) | (1u << W_UV) | (1u << W_CKV)) : 0u;
    const int ndense = 1536, ncomb = 4096, ncv = cvt_count(mask);
    const int tid_ = otid(), wid = tid_ >> 6, lane = tid_ & 63, l31 = lane & 31;
    for (int it = blockIdx.x; it < ndense + ncomb + ncv; it += gridDim.x) {
        if (it < ndense) { int sbase, S, head, qb;
            if (it < 768) { const int sq = it / 384, rem = it - sq * 384; head = rem >> 6; qb = rem & 63; sbase = NPR + sq * 8192; S = 8192; }
            else { const int k = it - 768, sq = k / 96, rem = k - sq * 96; head = rem >> 4; qb = rem & 15; sbase = sq * 2048; S = 2048; }
            bf16_t* mq = (bf16_t*)(ws + OFF_MQ); bf16_t* qrow = mq + (size_t)(sbase + qb * 128 + wid * 32 + l31) * 576 + head * 96;
            HookDense hk; hk.sc = 0.10206207261596575f * LOG2E; f32x16 O[2]; float m, lsum;
            attn_wave<6, 2>(qrow, (const bf16_t*)(ws + OFF_MK) + (size_t)sbase * 576 + head * 96, 576, (const bf16_t*)(ws + OFF_MVT) + (size_t)(head * 64) * T + sbase, (size_t)T, 0, S >> 5, hk, O, m, lsum);
            attn_store<2>(qrow, O, lsum); }
        else if (it < ndense + ncomb) { const int idx = (it - ndense) * 256 + tid_, cch = idx & 7, hs = (idx >> 3) & 3, t = idx >> 5;
            const float* lse = (const float*)(ws + OFF_LSE) + (size_t)t * 12 + hs; const float l0 = lse[0], l1 = lse[4], l2 = lse[8];
            const float M = fmaxf(l0, fmaxf(l1, l2)); float w0 = __expf(l0 - M), w1 = __expf(l1 - M), w2 = __expf(l2 - M); const float iw = 1.f / (w0 + w1 + w2); w0 *= iw; w1 *= iw; w2 *= iw;
            bf16_t* dq = (bf16_t*)(ws + OFF_DQ);
            const u32x4 a = *(const u32x4*)(dq + (size_t)t * 768 + hs * 64 + cch * 8), b = *(const u32x4*)(dq + (size_t)permtok(t, 1) * 768 + (4 + hs) * 64 + cch * 8),
                        c = *(const u32x4*)(dq + (size_t)permtok(t, 2) * 768 + (8 + hs) * 64 + cch * 8);
            u32x4 o;
#pragma unroll
            for (int e = 0; e < 4; ++e) o[e] = pk2(w0 * bflo(a[e]) + w1 * bflo(b[e]) + w2 * bflo(c[e]), w0 * bfhi(a[e]) + w1 * bfhi(b[e]) + w2 * bfhi(c[e]));
            *(u32x4*)(dq + (size_t)t * 768 + hs * 64 + cch * 8) = o; }
        else cvt_item(p, l + 1, mask, it - ndense - ncomb, lds);
    }
}

__device__ void phaseD(const P& p, int l, char* lds) {
    char* ws = ows(p.ws); const int n = swz_count(256, 8);
    for (int it = blockIdx.x; it < n; it += gridDim.x) { int mt, nt; if (!swz(it, 256, 8, mt, nt)) continue;
        SrcMix s; s.mq = (const bf16_t*)(ws + OFF_MQ); s.naq = (const bf16_t*)(ws + OFF_NAQ); s.dq = (const bf16_t*)(ws + OFF_DQ);
        EpiRes e; e.xin = xsrc(p, l, false); e.out = p.out;
        gemm_tile(s, (const bf16_t*)(ws + OFF_WT_O), 1024, nt * 128, mt * 128, 0, T, e, lds); }
}
__device__ void phaseE1(const P& p, int l, char* lds) {
    char* ws = ows(p.ws); const int n = swz_count(256, 8);
    for (int it = blockIdx.x; it < n; it += gridDim.x) { int mt, nt; if (!swz(it, 256, 8, mt, nt)) continue;
        EpiBf e; e.dst = (bf16_t*)(ws + OFF_XQ); e.ld = 1024;
        gemm_tile(xsrc(p, l, true), (const bf16_t*)(ws + OFF_WT_CQ), 1024, nt * 128, mt * 128, 0, T, e, lds); }
}
__device__ void phaseE2(const P& p, int l, char* lds) {
    char* ws = ows(p.ws); const unsigned mask = l < 3 ? ((1u << W_O) | (1u << W_CQ)) : 0u; const int nx = 2048, ncv = cvt_count(mask);
    const int tid_ = otid(), wid = tid_ >> 6, lane = tid_ & 63, l31 = lane & 31, hh = lane >> 5;
    for (int it = blockIdx.x; it < nx + ncv; it += gridDim.x) {
        if (it < nx) { const int dh = it & 1, head = (it >> 1) & 3, tb = it >> 3, t0 = tb * 128 + wid * 32, t = t0 + l31;
            const int batch = t0 < NPR ? (t0 >> 11) : 8 + ((t0 - NPR) >> 13);
            const bf16_t* qrow = (const bf16_t*)(ws + OFF_XQ) + (size_t)t * 1024 + head * 256;
            HookX hk; hk.ss = (const float*)(ws + OFF_MEMSS) + (size_t)(batch * 256) * 16 + head * 4; hk.hh = hh; hk.rq = 0.f; f32x16 O[4]; float m, lsum;
            attn_wave<16, 4>(qrow, (const bf16_t*)(ws + OFF_MEMK) + (size_t)(batch * 256) * 1024 + head * 256, 1024,
                             (const bf16_t*)(ws + OFF_MEMVT) + ((size_t)(batch * 1024 + head * 256 + dh * 128) << 8), (size_t)256, 0, 8, hk, O, m, lsum);
            attn_store<4>((bf16_t*)(ws + OFF_XO) + (size_t)t * 1024 + head * 256 + dh * 128, O, lsum); }
        else cvt_item(p, l + 1, mask, it - nx, lds);
    }
}
__device__ void phaseE3(const P& p, int l, char* lds) {
    char* ws = ows(p.ws); const int n = swz_count(256, 8);
    for (int it = blockIdx.x; it < n; it += gridDim.x) { int mt, nt; if (!swz(it, 256, 8, mt, nt)) continue;
        SrcB<false> s; s.p = (const bf16_t*)(ws + OFF_XO); s.ld = 1024;
        EpiRes e; e.xin = xsrc(p, l, true); e.out = p.out;
        gemm_tile(s, (const bf16_t*)(ws + OFF_WT_CO), 1024, nt * 128, mt * 128, 0, T, e, lds); }
}
__device__ void phaseF1(const P& p, int l, char* lds) {
    char* ws = ows(p.ws); const int n = swz_count(268, 44);
    for (int it = blockIdx.x; it < n; it += gridDim.x) { int mt, nt; if (!swz(it, 268, 44, mt, nt)) continue;
        int sbase, S, m; if (mt < 136) { const int sq = mt / 17; m = mt - sq * 17; sbase = sq * 2048; S = 2048; } else { const int k = mt - 136, sq = k / 66; m = k - sq * 66; sbase = NPR + sq * 8192; S = 8192; }
        EpiFfn e; e.act = (bf16_t*)(ws + OFF_ACT); e.cw = p.conv_w + (size_t)l * 3 * 5632; e.cb = p.conv_b + (size_t)l * 5632; e.sbase = sbase; e.S = S; e.pos0 = 126 * m - 1; e.ft = nt;
        gemm_tile(xsrc(p, l, true), (const bf16_t*)(ws + OFF_WT_UP), 1024, nt * 128, sbase + 126 * m - 1, sbase, sbase + S, e, lds); }
}
__device__ void phaseF2(const P& p, int l, char* lds) {
    char* ws = ows(p.ws); const unsigned mask = l < 3 ? ((1u << W_CO) | (1u << W_UP)) : 0u; const int n = swz_count(256, 8), ncv = cvt_count(mask);
    for (int it = blockIdx.x; it < n + ncv; it += gridDim.x) {
        if (it < n) { int mt, nt; if (!swz(it, 256, 8, mt, nt)) continue;
            SrcB<false> s; s.p = (const bf16_t*)(ws + OFF_ACT); s.ld = 2816;
            EpiRes e; e.xin = xsrc(p, l, true); e.out = p.out;
            gemm_tile(s, (const bf16_t*)(ws + OFF_WT_DOWN), 2816, nt * 128, mt * 128, 0, T, e, lds); }
        else cvt_item(p, l + 1, mask, it - n, lds);
    }
}

__global__ void __launch_bounds__(256, 2) mega(const P p) {
    __shared__ __attribute__((aligned(16))) char lds[LDS_BYTES];
    cg::grid_group grid = cg::this_grid();
    phase0(p, lds); grid.sync();
    for (int l = 0; l < 4; ++l) {
        phaseA(p, l, lds); grid.sync();
        phaseB(p, l, lds); grid.sync();
        phaseC(p, l, lds); grid.sync();
        phaseD(p, l, lds); grid.sync();
        phaseE1(p, l, lds); grid.sync();
        phaseE2(p, l, lds); grid.sync();
        phaseE3(p, l, lds); grid.sync();
        phaseF1(p, l, lds); grid.sync();
        phaseF2(p, l, lds); if (l < 3) grid.sync();
    }
}

extern "C" void kernel_launch(void* const* d_in, const int* in_sizes, int n_in, void* d_out, int out_size, void* d_ws, size_t ws_size, hipStream_t stream) {
    static int grid_blocks = 0;
    if (!grid_blocks) { int dev = 0, cus = 0, per_cu = 0; (void)hipGetDevice(&dev); (void)hipDeviceGetAttribute(&cus, hipDeviceAttributeMultiprocessorCount, dev);
        (void)hipOccupancyMaxActiveBlocksPerMultiprocessor(&per_cu, mega, 256, 0); if (per_cu > 2) per_cu = 2; grid_blocks = cus * per_cu; }
    if (ws_size < WS_NEED) { fprintf(stderr, "workspace too small: %zu < %zu\n", ws_size, (size_t)WS_NEED); return; }
    P p; memset(&p, 0, sizeof(p));
    const float** f = (const float**)&p.xp;
    for (int i = 0; i < 31; ++i) f[i] = (const float*)d_in[i];
    p.out = (float*)d_out; p.ws = (char*)d_ws;
    for (int i = 0; i < 32; ++i) p.inv32[i] = (float)pow(10000.0, -(double)i / 32.0);
    for (int i = 0; i < 16; ++i) p.inv16[i] = (float)pow(10000.0, -(double)i / 16.0);
    void* args[] = {(void*)&p};
    hipError_t e = hipLaunchCooperativeKernel((void*)mega, dim3(grid_blocks), dim3(256), args, 0, stream);
    if (e != hipSuccess) fprintf(stderr, "cooperative launch failed: %s (grid %d)\n", hipGetErrorString(e), grid_blocks);
}
```

```cpp
#include <hip/hip_runtime.h>
#include <hip/hip_cooperative_groups.h>
#include <cstdio>
#include <cmath>
#include <cstring>
namespace cg = cooperative_groups;

typedef unsigned short bf16_t;
typedef short bf16x8 __attribute__((ext_vector_type(8)));
typedef short s16x4 __attribute__((ext_vector_type(4)));
typedef float f32x16 __attribute__((ext_vector_type(16)));
typedef float f32x4 __attribute__((ext_vector_type(4)));
typedef float f32x2 __attribute__((ext_vector_type(2)));
typedef unsigned u32x4 __attribute__((ext_vector_type(4)));
typedef unsigned u32x2 __attribute__((ext_vector_type(2)));

#define MFMA32(a, b, c) __builtin_amdgcn_mfma_f32_32x32x16_bf16((a), (b), (c), 0, 0, 0)

constexpr int T = 32768;
constexpr int TP = T + 128;
constexpr int NPR = 16384;
constexpr float EPS = 1e-6f;
constexpr float LOG2E = 1.4426950408889634f;
constexpr int LDS_SSX = 139264;
constexpr int LDS_BYTES = 141568;

constexpr size_t SZ_WT_IN = (size_t)4096 * 1024 * 2, SZ_WT_UQ = (size_t)768 * 256 * 2, SZ_WT_UKV = (size_t)768 * 128 * 2,
                 SZ_WT_SQ = (size_t)1024 * 1024 * 2, SZ_WT_UP = (size_t)5632 * 1024 * 2, SZ_WT_DOWN = (size_t)1024 * 2816 * 2,
                 SZ_WT_CKV = (size_t)2048 * 1024 * 2;
constexpr size_t OFF_WT_IN = 0, OFF_WT_UQ = OFF_WT_IN + SZ_WT_IN, OFF_WT_UKV = OFF_WT_UQ + SZ_WT_UQ, OFF_WT_O = OFF_WT_UKV + SZ_WT_UKV,
                 OFF_WT_CQ = OFF_WT_O + SZ_WT_SQ, OFF_WT_CO = OFF_WT_CQ + SZ_WT_SQ, OFF_WT_UP = OFF_WT_CO + SZ_WT_SQ,
                 OFF_WT_DOWN = OFF_WT_UP + SZ_WT_UP, OFF_WT_CKV = OFF_WT_DOWN + SZ_WT_DOWN;
constexpr size_t OFF_MEMK = OFF_WT_CKV + SZ_WT_CKV;
constexpr size_t OFF_MEMVT = OFF_MEMK + (size_t)2560 * 1024 * 2;
constexpr size_t OFF_MEMSS = OFF_MEMVT + (size_t)2560 * 1024 * 2;
constexpr size_t OFF_ROPE32 = OFF_MEMSS + (size_t)2560 * 16 * 4;
constexpr size_t OFF_ROPE16 = OFF_ROPE32 + (size_t)8192 * 32 * 8;
constexpr size_t OFF_LSE = OFF_ROPE16 + (size_t)8192 * 16 * 8;
constexpr size_t OFF_SSP = OFF_LSE + (size_t)T * 12 * 4;
constexpr size_t OFF_ZSS = OFF_SSP + (size_t)T * 16 * 4;
constexpr size_t OFF_MEMB = OFF_ZSS + (size_t)T * 8 * 4;
constexpr size_t OFF_MEMSSP = OFF_MEMB + (size_t)2560 * 1024 * 2;
constexpr size_t OFF_CTR = OFF_MEMSSP + (size_t)2560 * 16 * 4;
constexpr size_t OFF_BAR = OFF_CTR + 256;
constexpr size_t OFF_MQ = OFF_BAR + 8192;
constexpr size_t OFF_MK = OFF_MQ + (size_t)T * 576 * 2;
constexpr size_t OFF_MVT = OFF_MK + (size_t)T * 576 * 2;
constexpr size_t OFF_XB = OFF_MK;
constexpr size_t OFF_Z = OFF_MK + (size_t)T * 1024 * 2;
constexpr size_t OFF_ZC = OFF_Z;
constexpr size_t OFF_NAQ = OFF_ZC + (size_t)T * 416 * 2;
constexpr size_t OFF_NAK = OFF_NAQ + (size_t)T * 384 * 2;
constexpr size_t OFF_NAVT = OFF_NAK + (size_t)T * 384 * 2;
constexpr size_t OFF_DQ = OFF_NAVT + (size_t)TP * 384 * 2;
constexpr size_t OFF_DK = OFF_DQ + (size_t)T * 768 * 2;
constexpr size_t OFF_DVT = OFF_DK + (size_t)T * 768 * 2;
constexpr size_t WS_NEED = OFF_DVT + (size_t)TP * 768 * 2;
constexpr size_t OFF_XQ = OFF_Z;
constexpr size_t OFF_XO = OFF_XQ + (size_t)T * 1024 * 2;
constexpr size_t OFF_ACT = OFF_Z;

struct P {
    const float *xp, *xs, *memp, *mems;
    const float *norm_mix, *w_in, *mla_q_norm, *mla_kv_norm, *w_uq, *w_uk, *w_uv, *mla_qn, *mla_kn, *na_qn, *na_kn, *na_rpb, *dil_qn,
        *dil_kn, *w_o, *norm_cross, *norm_mem, *w_cq, *w_ckv, *x_qn, *x_kn, *w_co, *norm_ffn, *w_up, *conv_w, *conv_b, *w_down;
    float* out;
    char* ws;
    float inv32[32];
    float inv16[16];
};

__device__ __forceinline__ unsigned pk2(float lo, float hi) { unsigned r; asm("v_cvt_pk_bf16_f32 %0, %1, %2" : "=v"(r) : "v"(lo), "v"(hi)); return r; }
__device__ __forceinline__ float bflo(unsigned u) { return __uint_as_float(u << 16); }
__device__ __forceinline__ float bfhi(unsigned u) { return __uint_as_float(u & 0xffff0000u); }
__device__ __forceinline__ bf16_t f2bf(float f) { return (bf16_t)(pk2(f, f) & 0xffffu); }
__device__ __forceinline__ int otid() { int t = threadIdx.x; asm volatile("" : "+v"(t)); return t; }
__device__ __forceinline__ int xcc_id() { return (int)(__builtin_amdgcn_s_getreg((3 << 11) | 20) & 7u); }
__device__ __forceinline__ char* ows(char* w) { asm volatile("" : "+s"(w)); return w; }
__device__ __forceinline__ float vmax3(float a, float b, float c) { return __builtin_amdgcn_fmed3f(__builtin_amdgcn_fmed3f(a, b, __builtin_inff()), c, __builtin_inff()); }
__device__ __forceinline__ int crow(int r, int hh) { return (r & 3) + 8 * (r >> 2) + 4 * hh; }
__device__ __forceinline__ void tokinfo(int t, int& sbase, int& S) {
    if (t < NPR) { S = 2048; sbase = t & ~2047; } else { S = 8192; sbase = NPR + ((t - NPR) & ~8191); }
}
__device__ __forceinline__ int permtok(int t, int g) {
    int sbase, S; tokinfo(t, sbase, S); const int sh = 2 * g, pos = t - sbase;
    return sbase + (pos & ((1 << sh) - 1)) * (S >> sh) + (pos >> sh);
}

__device__ __forceinline__ bool swz(int it, int MT, int NT, int& mt, int& nt) {
#ifdef XCD_CHUNKED
    const int x = (it >> 5) & 7, j = ((it >> 8) << 5) | (it & 31);
#else
    const int x = it & 7, j = it >> 3;
#endif
    const int m_lo = (MT * x) >> 3, m_hi = (MT * (x + 1)) >> 3, mc = m_hi - m_lo;
    if (j >= mc * NT) return false;
    const int grp = j / (8 * NT), rem = j - grp * 8 * NT;
    int gsz = mc - grp * 8; gsz = gsz > 8 ? 8 : gsz;
    nt = rem / gsz; mt = m_lo + grp * 8 + (rem - nt * gsz); return true;
}
#ifdef XCD_CHUNKED
__host__ __device__ constexpr int swz_count(int MT, int NT) { return ((((MT + 7) / 8) * NT + 31) / 32) * 256; }
#else
__host__ __device__ constexpr int swz_count(int MT, int NT) { return 8 * ((MT + 7) / 8) * NT; }
#endif

struct CvtJob { const float* src; bf16_t* dst; const float* gain; int K, N, mode; };
__device__ __forceinline__ int rowmap(int mode, int n) {
    if (mode == 1) return n < 416 ? n : n + 96;
    if (mode == 2) return (n / 96) * 128 + (n % 96);
    if (mode == 3) { const int g = n >= 2816, f = g ? n - 2816 : n; return (f >> 7) * 256 + g * 128 + (f & 127); }
    return n;
}
__device__ __forceinline__ void cvt_tile(const CvtJob& j, int pair, int ntiles, char* lds) {
    const int tid8 = otid(), half = tid8 >> 8, tid = tid8 & 255, tile = pair * 2 + half; const bool on = tile < ntiles;
    const int ntn = (j.N + 63) >> 6, tk = tile / ntn, tn = tile - tk * ntn, k0 = tk * 64, n0 = tn * 64;
    float* tl = (float*)lds + half * (64 * 65);
    if (on) { const int tx = tid & 63, ty = tid >> 6, n = n0 + tx;
#pragma unroll
      for (int i = 0; i < 16; ++i) { const int k = k0 + ty * 16 + i; float v = (n < j.N) ? j.src[(size_t)k * j.N + n] : 0.f; if (j.gain) v *= j.gain[k]; tl[tx * 65 + ty * 16 + i] = v; } }
    __syncthreads();
    if (on) { const int rn = tid >> 2, c = tid & 3, n = n0 + rn;
      if (n < j.N) { const float* s = tl + rn * 65 + c * 16; bf16_t* d = j.dst + (size_t)rowmap(j.mode, n) * j.K + k0 + c * 16;
        u32x4 a = {pk2(s[0], s[1]), pk2(s[2], s[3]), pk2(s[4], s[5]), pk2(s[6], s[7])}, b = {pk2(s[8], s[9]), pk2(s[10], s[11]), pk2(s[12], s[13]), pk2(s[14], s[15])};
        *(u32x4*)d = a; *(u32x4*)(d + 8) = b; } }
    __syncthreads();
}
enum { W_IN = 0, W_UQ, W_UK, W_UV, W_O, W_CQ, W_CO, W_UP, W_DOWN, W_CKV, W_NUM };
__host__ __device__ constexpr int cvt_tiles(int w) {
    return w == W_IN ? 16 * 61 : w == W_UQ ? 4 * 9 : (w == W_UK || w == W_UV) ? 2 * 6 : (w == W_O || w == W_CQ || w == W_CO) ? 256 : w == W_UP ? 16 * 88 : w == W_DOWN ? 44 * 16 : 16 * 32;
}
__host__ __device__ constexpr int cvt_count(unsigned mask) { int n = 0; for (int w = 0; w < W_NUM; ++w) if (mask & (1u << w)) n += (cvt_tiles(w) + 1) / 2; return n; }
__device__ __forceinline__ CvtJob get_cvt(const P& p, int l, int w) {
    CvtJob j; j.gain = nullptr; j.mode = 0;
    switch (w) {
    case W_IN: j.src = p.w_in + (size_t)l * 1024 * 3872; j.dst = (bf16_t*)(p.ws + OFF_WT_IN); j.gain = p.norm_mix + l * 1024; j.K = 1024; j.N = 3872; j.mode = 1; break;
    case W_UQ: j.src = p.w_uq + (size_t)l * 256 * 576; j.dst = (bf16_t*)(p.ws + OFF_WT_UQ); j.gain = p.mla_q_norm + l * 256; j.K = 256; j.N = 576; j.mode = 2; break;
    case W_UK: j.src = p.w_uk + (size_t)l * 128 * 384; j.dst = (bf16_t*)(p.ws + OFF_WT_UKV); j.gain = p.mla_kv_norm + l * 128; j.K = 128; j.N = 384; break;
    case W_UV: j.src = p.w_uv + (size_t)l * 128 * 384; j.dst = (bf16_t*)(p.ws + OFF_WT_UKV) + 384 * 128; j.gain = p.mla_kv_norm + l * 128; j.K = 128; j.N = 384; break;
    case W_O: j.src = p.w_o + (size_t)l * 1024 * 1024; j.dst = (bf16_t*)(p.ws + OFF_WT_O); j.K = 1024; j.N = 1024; break;
    case W_CQ: j.src = p.w_cq + (size_t)l * 1024 * 1024; j.dst = (bf16_t*)(p.ws + OFF_WT_CQ); j.gain = p.norm_cross + l * 1024; j.K = 1024; j.N = 1024; break;
    case W_CO: j.src = p.w_co + (size_t)l * 1024 * 1024; j.dst = (bf16_t*)(p.ws + OFF_WT_CO); j.K = 1024; j.N = 1024; break;
    case W_UP: j.src = p.w_up + (size_t)l * 1024 * 5632; j.dst = (bf16_t*)(p.ws + OFF_WT_UP); j.gain = p.norm_ffn + l * 1024; j.K = 1024; j.N = 5632; j.mode = 3; break;
    case W_DOWN: j.src = p.w_down + (size_t)l * 2816 * 1024; j.dst = (bf16_t*)(p.ws + OFF_WT_DOWN); j.K = 2816; j.N = 1024; break;
    default: j.src = p.w_ckv + (size_t)l * 1024 * 2048; j.dst = (bf16_t*)(p.ws + OFF_WT_CKV); j.gain = p.norm_mem + l * 1024; j.K = 1024; j.N = 2048; break;
    }
    return j;
}
__device__ __forceinline__ void cvt_item(const P& p, int l, unsigned mask, int it, char* lds) {
    for (int w = 0; w < W_NUM; ++w) if (mask & (1u << w)) { const int n = (cvt_tiles(w) + 1) / 2; if (it < n) { CvtJob j = get_cvt(p, l, w); cvt_tile(j, it, cvt_tiles(w), lds); return; } it -= n; }
}

struct SrcX {
    const float *p0, *p1; int split;
    __device__ __forceinline__ const float* row(int t) const { return (t < split ? p0 : p1) + (size_t)t * 1024; }
};
struct SrcXb {
    const bf16_t* xb; const float* ssp;
    __device__ __forceinline__ const bf16_t* ptrb(int t, int k0) const { return xb + (size_t)t * 1024 + k0; }
    __device__ __forceinline__ float rstd(int t) const { const f32x4* q = (const f32x4*)(ssp + (size_t)t * 16); const f32x4 a = q[0], b = q[1], c = q[2], d = q[3];
        return rsqrtf(((a[0] + a[1] + a[2] + a[3]) + (b[0] + b[1] + b[2] + b[3]) + (c[0] + c[1] + c[2] + c[3]) + (d[0] + d[1] + d[2] + d[3])) * (1.f / 1024.f) + EPS); }
};
template <int NSS> struct SrcZ {
    const bf16_t* p; const float* zss;
    __device__ __forceinline__ const bf16_t* ptrb(int t, int k0) const { return p + (size_t)t * 416 + k0; }
    __device__ __forceinline__ float rstd(int t) const { float a = 0.f;
#pragma unroll
        for (int i = 0; i < NSS; ++i) a += zss[(size_t)t * 8 + i];
        return rsqrtf(a * (1.f / (64.f * NSS)) + EPS); }
};
struct SrcB {
    const bf16_t* p; int ld;
    __device__ __forceinline__ const bf16_t* ptrb(int t, int k0) const { return p + (size_t)t * ld + k0; }
    __device__ __forceinline__ float rstd(int) const { return 1.f; }
};
struct SrcMix {
    const bf16_t *mq, *naq, *dq;
    __device__ __forceinline__ const bf16_t* ptrb(int t, int k0) const {
        if (k0 < 384) return mq + (size_t)t * 576 + (k0 >> 6) * 96 + (k0 & 63);
        if (k0 < 768) return naq + (size_t)t * 384 + (k0 - 384);
        return dq + (size_t)t * 768 + (k0 - 768);
    }
    __device__ __forceinline__ float rstd(int) const { return 1.f; }
};
struct TileCtx { int f0, tok0, wm, wn, l31, hh, wid, lane; float rs[2]; };

#define WAIT_V(n) asm volatile("s_waitcnt vmcnt(%0)" ::"n"(n) : "memory")
#define RAW_BARRIER() do { asm volatile("s_waitcnt lgkmcnt(0)" ::: "memory"); __builtin_amdgcn_s_barrier(); } while (0)
#define GLDS(g, l) __builtin_amdgcn_global_load_lds((const unsigned*)(g), (unsigned*)(l), 16, 0, 0)

constexpr int STG = 65536;
template <class Src, class Epi>
__device__ __forceinline__ void gemm_tile(const Src src, const bf16_t* __restrict__ Wt, const int K, const int f0, const int tok0, const int vlo, const int vhi,
                                          const Epi epi, char* lds) {
    const int tid = otid(), lane = tid & 63, wid = tid >> 6, wm = wid >> 2, wn = wid & 3, l31 = lane & 31, hh = lane >> 5;
    const int q = lane >> 3, ch8 = ((lane & 7) ^ ((4 * (wid & 1) + (q >> 1)) & 7)) * 8;
    int ra[4];
#pragma unroll
    for (int i = 0; i < 4; ++i) { int r = tok0 + 8 * wid + 64 * i + q; ra[i] = r < vlo ? vlo : (r >= vhi ? vhi - 1 : r); }
    const bf16_t* wp0 = Wt + (size_t)(f0 + 8 * wid + q) * K + ch8; const size_t w64 = (size_t)64 * K;
    const int y = (l31 >> 1) & 7;
    const int oW = (wm * 128 + l31) * 128, oA = 32768 + (wn * 64 + l31) * 128;
    int cx[4];
#pragma unroll
    for (int ks = 0; ks < 4; ++ks) cx[ks] = ((2 * ks + hh) ^ y) << 4;
    f32x16 acc[4][2];
#pragma unroll
    for (int i = 0; i < 4; ++i)
#pragma unroll
        for (int j = 0; j < 2; ++j)
#pragma unroll
            for (int r = 0; r < 16; ++r) acc[i][j][r] = 0.f;
    const int nk = K >> 6;
#define STAGE(st_, k0_) do { char* d_ = lds + (st_) * STG + wid * 1024;                                                                                                  \
        _Pragma("unroll") for (int i_ = 0; i_ < 4; ++i_) GLDS(wp0 + i_ * w64 + (k0_), d_ + i_ * 8192);                                                                   \
        _Pragma("unroll") for (int i_ = 0; i_ < 4; ++i_) GLDS(src.ptrb(ra[i_], (k0_)) + ch8, d_ + 32768 + i_ * 8192); } while (0)
#define KPAIR(k0_, k1_) do {                                                               \
        const bf16x8 b00 = *(const bf16x8*)(sb + oA + cx[k0_]), b01 = *(const bf16x8*)(sb + oA + 4096 + cx[k0_]), a00 = *(const bf16x8*)(sb + oW + cx[k0_]),             \
                     a01 = *(const bf16x8*)(sb + oW + 4096 + cx[k0_]), a02 = *(const bf16x8*)(sb + oW + 8192 + cx[k0_]), a03 = *(const bf16x8*)(sb + oW + 12288 + cx[k0_]); \
        const bf16x8 b10 = *(const bf16x8*)(sb + oA + cx[k1_]), b11 = *(const bf16x8*)(sb + oA + 4096 + cx[k1_]), a10 = *(const bf16x8*)(sb + oW + cx[k1_]),             \
                     a11 = *(const bf16x8*)(sb + oW + 4096 + cx[k1_]), a12 = *(const bf16x8*)(sb + oW + 8192 + cx[k1_]), a13 = *(const bf16x8*)(sb + oW + 12288 + cx[k1_]); \
        __builtin_amdgcn_sched_barrier(0);                                                                                                                               \
        acc[0][0] = MFMA32(a00, b00, acc[0][0]); acc[0][1] = MFMA32(a00, b01, acc[0][1]); acc[1][0] = MFMA32(a01, b00, acc[1][0]); acc[1][1] = MFMA32(a01, b01, acc[1][1]); \
        acc[2][0] = MFMA32(a02, b00, acc[2][0]); acc[2][1] = MFMA32(a02, b01, acc[2][1]); acc[3][0] = MFMA32(a03, b00, acc[3][0]); acc[3][1] = MFMA32(a03, b01, acc[3][1]); \
        acc[0][0] = MFMA32(a10, b10, acc[0][0]); acc[0][1] = MFMA32(a10, b11, acc[0][1]); acc[1][0] = MFMA32(a11, b10, acc[1][0]); acc[1][1] = MFMA32(a11, b11, acc[1][1]); \
        acc[2][0] = MFMA32(a12, b10, acc[2][0]); acc[2][1] = MFMA32(a12, b11, acc[2][1]); acc[3][0] = MFMA32(a13, b10, acc[3][0]); acc[3][1] = MFMA32(a13, b11, acc[3][1]); \
        __builtin_amdgcn_sched_barrier(0); } while (0)
    STAGE(0, 0);
    for (int kt = 0; kt < nk; ++kt) {
        WAIT_V(0);
        RAW_BARRIER();
        if (kt + 1 < nk) STAGE((kt + 1) & 1, (kt + 1) * 64);
        const char* sb = lds + (kt & 1) * STG;
        KPAIR(0, 1); KPAIR(2, 3);
    }
#undef STAGE
#undef KPAIR
    RAW_BARRIER();
    TileCtx c; c.tok0 = tok0; c.wm = wm; c.wn = wn; c.l31 = l31; c.hh = hh; c.wid = wid; c.lane = lane;
    { int t0 = tok0 + wn * 64 + l31, t1 = t0 + 32; t0 = t0 < vlo ? vlo : (t0 >= vhi ? vhi - 1 : t0); t1 = t1 < vlo ? vlo : (t1 >= vhi ? vhi - 1 : t1);
      c.rs[0] = src.rstd(t0); c.rs[1] = src.rstd(t1); }
    if constexpr (Epi::FULL) { c.f0 = f0; epi(acc, c, lds); }
    else {
        c.f0 = f0 + wm * 64; epi(*(f32x16(*)[2][2])&acc[0], c, lds);
        c.f0 = f0 + wm * 64 + 64; epi(*(f32x16(*)[2][2])&acc[2], c, lds);
    }
    RAW_BARRIER();
}

__device__ __forceinline__ void st4(bf16_t* p, float a, float b, float c, float d) { u32x2 w = {pk2(a, b), pk2(c, d)}; *(u32x2*)p = w; }
constexpr int EPI_WREG = 17408;

template <class RowPtr>
__device__ __forceinline__ void put_rows_bf16(char* lds, const TileCtx& c, const f32x16 (&v)[2][2], const int nch, RowPtr rowptr) {
    bf16_t* R = (bf16_t*)(lds + c.wid * EPI_WREG);
#pragma unroll
    for (int nt = 0; nt < 2; ++nt)
#pragma unroll
        for (int mt = 0; mt < 2; ++mt)
#pragma unroll
            for (int g = 0; g < 4; ++g) st4(R + (nt * 32 + c.l31) * 72 + mt * 32 + 8 * g + 4 * c.hh, v[mt][nt][4 * g], v[mt][nt][4 * g + 1], v[mt][nt][4 * g + 2], v[mt][nt][4 * g + 3]);
    const int rr = c.lane >> 3, ch = c.lane & 7;
#pragma unroll
    for (int i = 0; i < 8; ++i) { const int tl = 8 * i + rr; const u32x4 w = *(const u32x4*)(R + tl * 72 + ch * 8); if (ch < nch) *(u32x4*)(rowptr(tl) + ch * 8) = w; }
}

struct EpiIn {
    static constexpr bool FULL = false;
    bf16_t *zc, *naq, *nak, *navT, *dq, *dk, *dvT; float* zss; const float *na_qn, *na_kn, *dil_qn, *dil_kn; const f32x2* rope32;
    __device__ __forceinline__ void operator()(f32x16 (&acc)[2][2], const TileCtx& c, char*) const {
        const int fw = c.f0 + c.wm * 64;
        if (fw >= 3968) return;
        if (fw < 512) {
#pragma unroll
            for (int nt = 0; nt < 2; ++nt) { const int t = c.tok0 + c.wn * 64 + nt * 32 + c.l31; const float rs = c.rs[nt]; float ss = 0.f;
#pragma unroll
                for (int mt = 0; mt < 2; ++mt) { const int fb = fw + mt * 32; if (fb >= 416) continue;
#pragma unroll
                    for (int r = 0; r < 16; ++r) { const float v = acc[mt][nt][r] * rs; acc[mt][nt][r] = v; ss += v * v; }
#pragma unroll
                    for (int g = 0; g < 4; ++g) st4(zc + (size_t)t * 416 + fb + 8 * g + 4 * c.hh, acc[mt][nt][4 * g], acc[mt][nt][4 * g + 1], acc[mt][nt][4 * g + 2], acc[mt][nt][4 * g + 3]); }
                ss += __shfl_xor(ss, 32); if (c.hh == 0 && fw < 384) zss[(size_t)t * 8 + (fw >> 6)] = ss; }
        } else if (fw < 1664) {
            const int pf = fw - 512, which = pf / 384, head = (pf - which * 384) >> 6;
            if (which < 2) { const float* gain = which ? na_kn : na_qn; bf16_t* dst = which ? nak : naq;
#pragma unroll
                for (int nt = 0; nt < 2; ++nt) { const int t = c.tok0 + c.wn * 64 + nt * 32 + c.l31; const float rs = c.rs[nt]; float ss = 0.f;
#pragma unroll
                    for (int mt = 0; mt < 2; ++mt)
#pragma unroll
                        for (int r = 0; r < 16; ++r) { const float v = acc[mt][nt][r] * rs; acc[mt][nt][r] = v; ss += v * v; }
                    ss += __shfl_xor(ss, 32); const float rq = rsqrtf(ss * (1.f / 64.f) + EPS);
#pragma unroll
                    for (int mt = 0; mt < 2; ++mt)
#pragma unroll
                        for (int g = 0; g < 4; ++g) { const int d = mt * 32 + 8 * g + 4 * c.hh; const f32x4 gn = *(const f32x4*)(gain + d);
                            st4(dst + (size_t)t * 384 + head * 64 + d, acc[mt][nt][4 * g] * rq * gn[0], acc[mt][nt][4 * g + 1] * rq * gn[1], acc[mt][nt][4 * g + 2] * rq * gn[2], acc[mt][nt][4 * g + 3] * rq * gn[3]); } }
            } else {
#pragma unroll
                for (int nt = 0; nt < 2; ++nt) { const int t = c.tok0 + c.wn * 64 + nt * 32 + c.l31; const float rs = c.rs[nt];
#pragma unroll
                    for (int mt = 0; mt < 2; ++mt)
#pragma unroll
                        for (int r = 0; r < 16; ++r) navT[(size_t)(head * 64 + mt * 32 + crow(r, c.hh)) * TP + t] = f2bf(acc[mt][nt][r] * rs); }
            }
        } else {
            const int pf = fw - 1664, which = pf / 768, h12 = (pf - which * 768) >> 6, g4 = h12 >> 2;
#pragma unroll
            for (int nt = 0; nt < 2; ++nt) { const int t = c.tok0 + c.wn * 64 + nt * 32 + c.l31; const float rs = c.rs[nt];
                int sbase, S; tokinfo(t, sbase, S); const int pos = t - sbase, sh = 2 * g4; const int tp = sbase + (pos & ((1 << sh) - 1)) * (S >> sh) + (pos >> sh);
                if (which < 2) { const float* gain = which ? dil_kn : dil_qn; bf16_t* dst = which ? dk : dq; float ss = 0.f;
#pragma unroll
                    for (int mt = 0; mt < 2; ++mt)
#pragma unroll
                        for (int r = 0; r < 16; ++r) { const float v = acc[mt][nt][r] * rs; acc[mt][nt][r] = v; ss += v * v; }
                    ss += __shfl_xor(ss, 32); const float rq = rsqrtf(ss * (1.f / 64.f) + EPS);
#pragma unroll
                    for (int g = 0; g < 4; ++g) { const int d = 8 * g + 4 * c.hh; const f32x4 g1 = *(const f32x4*)(gain + d), g2 = *(const f32x4*)(gain + 32 + d);
                        const f32x4 cs0 = *(const f32x4*)(rope32 + pos * 32 + d), cs1 = *(const f32x4*)(rope32 + pos * 32 + d + 2);
                        float o1[4], o2[4];
#pragma unroll
                        for (int j = 0; j < 4; ++j) { const float x1 = acc[0][nt][4 * g + j] * rq * g1[j], x2 = acc[1][nt][4 * g + j] * rq * g2[j];
                            const float cc = j < 2 ? cs0[2 * j] : cs1[2 * (j - 2)], sn = j < 2 ? cs0[2 * j + 1] : cs1[2 * (j - 2) + 1];
                            o1[j] = x1 * cc - x2 * sn; o2[j] = x2 * cc + x1 * sn; }
                        st4(dst + (size_t)tp * 768 + h12 * 64 + d, o1[0], o1[1], o1[2], o1[3]); st4(dst + (size_t)tp * 768 + h12 * 64 + 32 + d, o2[0], o2[1], o2[2], o2[3]); }
                } else {
#pragma unroll
                    for (int mt = 0; mt < 2; ++mt)
#pragma unroll
                        for (int r = 0; r < 16; ++r) dvT[(size_t)(h12 * 64 + mt * 32 + crow(r, c.hh)) * TP + tp] = f2bf(acc[mt][nt][r] * rs);
                } }
        }
    }
};

struct EpiUq {
    static constexpr bool FULL = true;
    bf16_t* mq; const float* qn; const f32x2* rope16;
    __device__ __forceinline__ void operator()(f32x16 (&acc)[4][2], const TileCtx& c, char*) const {
        const int head = (c.f0 >> 7) + c.wm;
#pragma unroll
        for (int nt = 0; nt < 2; ++nt) { const int t = c.tok0 + c.wn * 64 + nt * 32 + c.l31; float ss = 0.f;
#pragma unroll
            for (int mt = 0; mt < 3; ++mt)
#pragma unroll
                for (int r = 0; r < 16; ++r) { const float v = acc[mt][nt][r] * c.rs[nt]; acc[mt][nt][r] = v; ss += v * v; }
            ss += __shfl_xor(ss, 32); const float rq = rsqrtf(ss * (1.f / 96.f) + EPS);
            int sbase, S; tokinfo(t, sbase, S); const int pos = t - sbase; bf16_t* dst = mq + (size_t)t * 576 + head * 96;
#pragma unroll
            for (int mt = 0; mt < 2; ++mt)
#pragma unroll
                for (int g = 0; g < 4; ++g) { const int d = mt * 32 + 8 * g + 4 * c.hh; const f32x4 gn = *(const f32x4*)(qn + d);
                    st4(dst + d, acc[mt][nt][4 * g] * rq * gn[0], acc[mt][nt][4 * g + 1] * rq * gn[1], acc[mt][nt][4 * g + 2] * rq * gn[2], acc[mt][nt][4 * g + 3] * rq * gn[3]); }
#pragma unroll
            for (int g = 0; g < 2; ++g) { const int i = 8 * g + 4 * c.hh; const f32x4 g1 = *(const f32x4*)(qn + 64 + i), g2 = *(const f32x4*)(qn + 80 + i);
                const f32x4 cs0 = *(const f32x4*)(rope16 + pos * 16 + i), cs1 = *(const f32x4*)(rope16 + pos * 16 + i + 2); float o1[4], o2[4];
#pragma unroll
                for (int j = 0; j < 4; ++j) { const float x1 = acc[2][nt][4 * g + j] * rq * g1[j], x2 = acc[2][nt][8 + 4 * g + j] * rq * g2[j];
                    const float cc = j < 2 ? cs0[2 * j] : cs1[2 * (j - 2)], sn = j < 2 ? cs0[2 * j + 1] : cs1[2 * (j - 2) + 1];
                    o1[j] = x1 * cc - x2 * sn; o2[j] = x2 * cc + x1 * sn; }
                st4(dst + 64 + i, o1[0], o1[1], o1[2], o1[3]); st4(dst + 80 + i, o2[0], o2[1], o2[2], o2[3]); } }
    }
};

struct EpiUkv {
    static constexpr bool FULL = false;
    bf16_t *mk, *mvT; const bf16_t* zc; const float* kn; const f32x2* rope16;
    __device__ __forceinline__ void operator()(f32x16 (&acc)[2][2], const TileCtx& c, char*) const {
        const int fw = c.f0 + c.wm * 64;
        if (fw < 384) { const int head = fw >> 6;
#pragma unroll
            for (int nt = 0; nt < 2; ++nt) { const int t = c.tok0 + c.wn * 64 + nt * 32 + c.l31; const float rs = c.rs[nt]; float ss = 0.f;
#pragma unroll
                for (int mt = 0; mt < 2; ++mt)
#pragma unroll
                    for (int r = 0; r < 16; ++r) { const float v = acc[mt][nt][r] * rs; acc[mt][nt][r] = v; ss += v * v; }
                const bf16_t* krp = zc + (size_t)t * 416 + 384 + 8 * c.hh; const u32x4 ka = *(const u32x4*)krp, kb = *(const u32x4*)(krp + 16);
                float x1[8], x2[8];
#pragma unroll
                for (int e = 0; e < 4; ++e) { x1[2 * e] = bflo(ka[e]); x1[2 * e + 1] = bfhi(ka[e]); x2[2 * e] = bflo(kb[e]); x2[2 * e + 1] = bfhi(kb[e]); }
#pragma unroll
                for (int e = 0; e < 8; ++e) ss += x1[e] * x1[e] + x2[e] * x2[e];
                ss += __shfl_xor(ss, 32); const float rq = rsqrtf(ss * (1.f / 96.f) + EPS);
                int sbase, S; tokinfo(t, sbase, S); const int pos = t - sbase; bf16_t* dst = mk + (size_t)t * 576 + head * 96;
#pragma unroll
                for (int mt = 0; mt < 2; ++mt)
#pragma unroll
                    for (int g = 0; g < 4; ++g) { const int d = mt * 32 + 8 * g + 4 * c.hh; const f32x4 gn = *(const f32x4*)(kn + d);
                        st4(dst + d, acc[mt][nt][4 * g] * rq * gn[0], acc[mt][nt][4 * g + 1] * rq * gn[1], acc[mt][nt][4 * g + 2] * rq * gn[2], acc[mt][nt][4 * g + 3] * rq * gn[3]); }
                float o1[8], o2[8];
#pragma unroll
                for (int e = 0; e < 8; ++e) { const int i = 8 * c.hh + e; const f32x2 cs = rope16[pos * 16 + i]; const float a = x1[e] * rq * kn[64 + i], b = x2[e] * rq * kn[80 + i];
                    o1[e] = a * cs[0] - b * cs[1]; o2[e] = b * cs[0] + a * cs[1]; }
                u32x4 w1 = {pk2(o1[0], o1[1]), pk2(o1[2], o1[3]), pk2(o1[4], o1[5]), pk2(o1[6], o1[7])}, w2 = {pk2(o2[0], o2[1]), pk2(o2[2], o2[3]), pk2(o2[4], o2[5]), pk2(o2[6], o2[7])};
                *(u32x4*)(dst + 64 + 8 * c.hh) = w1; *(u32x4*)(dst + 80 + 8 * c.hh) = w2; }
        } else { const int head = (fw - 384) >> 6;
#pragma unroll
            for (int nt = 0; nt < 2; ++nt) { const int t = c.tok0 + c.wn * 64 + nt * 32 + c.l31; const float rs = c.rs[nt];
#pragma unroll
                for (int mt = 0; mt < 2; ++mt)
#pragma unroll
                    for (int r = 0; r < 16; ++r) mvT[(size_t)(head * 64 + mt * 32 + crow(r, c.hh)) * TP + t] = f2bf(acc[mt][nt][r] * rs); }
        }
    }
};

struct EpiRes {
    static constexpr bool FULL = false;
    SrcX xin; float* out; bf16_t* xb; float* ssp;
    __device__ __forceinline__ void operator()(f32x16 (&acc)[2][2], const TileCtx& c, char* lds) const {
        float* R = (float*)(lds + c.wid * EPI_WREG);
#pragma unroll
        for (int nt = 0; nt < 2; ++nt)
#pragma unroll
            for (int mt = 0; mt < 2; ++mt)
#pragma unroll
                for (int g = 0; g < 4; ++g) { f32x4 v = {acc[mt][nt][4 * g], acc[mt][nt][4 * g + 1], acc[mt][nt][4 * g + 2], acc[mt][nt][4 * g + 3]}; *(f32x4*)(R + (nt * 32 + c.l31) * 68 + mt * 32 + 8 * g + 4 * c.hh) = v; }
        const int rr = c.lane >> 4, cc = c.lane & 15, fb = c.f0 + c.wm * 64, f = fb + 4 * cc, t0 = c.tok0 + c.wn * 64 + rr;
        const float* xr = xin.row(t0) + f; float* orow = out + (size_t)t0 * 1024 + f; bf16_t* brow = xb + (size_t)t0 * 1024 + f; float* sp = ssp + (size_t)t0 * 16 + (fb >> 6);
        const float* Rr = R + rr * 68 + 4 * cc;
#pragma unroll 4
        for (int i = 0; i < 16; ++i) { f32x4 v = *(const f32x4*)Rr; const f32x4 xv = *(const f32x4*)xr; v[0] += xv[0]; v[1] += xv[1]; v[2] += xv[2]; v[3] += xv[3];
            *(f32x4*)orow = v; st4(brow, v[0], v[1], v[2], v[3]);
            float ss = v[0] * v[0] + v[1] * v[1] + v[2] * v[2] + v[3] * v[3];
            ss += __shfl_xor(ss, 1); ss += __shfl_xor(ss, 2); ss += __shfl_xor(ss, 4); ss += __shfl_xor(ss, 8);
            if (cc == 0) *sp = ss;
            Rr += 4 * 68; xr += 4096; orow += 4096; brow += 4096; sp += 64; }
    }
};

struct EpiQLds {
    static constexpr bool FULL = true;
    __device__ __forceinline__ void operator()(f32x16 (&acc)[4][2], const TileCtx& c, char* lds) const {
#pragma unroll
        for (int nt = 0; nt < 2; ++nt) { const int row = c.wn * 64 + nt * 32 + c.l31; const float rs = c.rs[nt];
#pragma unroll
            for (int mt = 0; mt < 4; ++mt)
#pragma unroll
                for (int g = 0; g < 4; ++g) { const int chunk = c.wm * 16 + mt * 4 + g;
                    st4((bf16_t*)(lds + row * 512 + ((chunk ^ (row & 15)) << 4) + 8 * c.hh), acc[mt][nt][4 * g] * rs, acc[mt][nt][4 * g + 1] * rs, acc[mt][nt][4 * g + 2] * rs, acc[mt][nt][4 * g + 3] * rs); } }
    }
};
struct EpiNull {
    static constexpr bool FULL = true; float* out;
    __device__ __forceinline__ void operator()(f32x16 (&acc)[4][2], const TileCtx& c, char*) const { float a = 0.f;
#pragma unroll
        for (int i = 0; i < 4; ++i)
#pragma unroll
            for (int j = 0; j < 2; ++j)
#pragma unroll
                for (int r = 0; r < 16; ++r) a += acc[i][j][r];
        if (a == 12345.678f) out[c.l31] = a; }
};
struct EpiBf {
    static constexpr bool FULL = false;
    bf16_t* dst; int ld;
    __device__ __forceinline__ void operator()(f32x16 (&acc)[2][2], const TileCtx& c, char* lds) const {
#pragma unroll
        for (int nt = 0; nt < 2; ++nt)
#pragma unroll
            for (int mt = 0; mt < 2; ++mt)
#pragma unroll
                for (int r = 0; r < 16; ++r) acc[mt][nt][r] *= c.rs[nt];
        bf16_t* base = dst + (size_t)(c.tok0 + c.wn * 64) * ld + c.f0 + c.wm * 64; const int ld_ = ld;
        put_rows_bf16(lds, c, acc, 8, [&](int tl) { return base + (size_t)tl * ld_; });
    }
};

struct EpiMem {
    static constexpr bool FULL = true;
    bf16_t *memK, *memVT; const float *xkn, *xqn;
    __device__ __forceinline__ void operator()(f32x16 (&acc)[4][2], const TileCtx& c, char* lds) const {
        const int mb = c.tok0 + c.wn * 64;
        if (c.f0 < 1024) { float* ssx = (float*)(lds + LDS_SSX);
#pragma unroll
            for (int nt = 0; nt < 2; ++nt) { float ss = 0.f;
#pragma unroll
                for (int mt = 0; mt < 4; ++mt)
#pragma unroll
                    for (int r = 0; r < 16; ++r) { const float v = acc[mt][nt][r] * c.rs[nt]; acc[mt][nt][r] = v; ss += v * v; }
                ss += __shfl_xor(ss, 32); if (c.hh == 0) ssx[c.wm * 256 + c.wn * 64 + nt * 32 + c.l31] = ss; }
            __syncthreads();
            float rk[2];
#pragma unroll
            for (int nt = 0; nt < 2; ++nt) { const int tl = c.wn * 64 + nt * 32 + c.l31; rk[nt] = rsqrtf((ssx[tl] + ssx[256 + tl]) * (1.f / 256.f) + EPS) * 0.0625f; }
            bf16_t* base = memK + (size_t)mb * 1024 + c.f0 + c.wm * 128;
#pragma unroll
            for (int hf = 0; hf < 2; ++hf) {
#pragma unroll
                for (int m2 = 0; m2 < 2; ++m2)
#pragma unroll
                    for (int g = 0; g < 4; ++g) { const int mt = 2 * hf + m2, d = c.wm * 128 + mt * 32 + 8 * g + 4 * c.hh; const f32x4 gk = *(const f32x4*)(xkn + d), gq = *(const f32x4*)(xqn + d);
#pragma unroll
                        for (int j = 0; j < 4; ++j) { acc[mt][0][4 * g + j] *= rk[0] * gk[j] * gq[j]; acc[mt][1][4 * g + j] *= rk[1] * gk[j] * gq[j]; } }
                bf16_t* bh = base + hf * 64;
                put_rows_bf16(lds, c, *(f32x16(*)[2][2])&acc[2 * hf], 8, [&](int tl) { return bh + (size_t)tl * 1024; });
                asm volatile("" ::: "memory");
            }
        } else {
#pragma unroll
            for (int nt = 0; nt < 2; ++nt) { const int m = mb + nt * 32 + c.l31, b = m >> 8, key = m & 255; const float rs = c.rs[nt];
#pragma unroll
                for (int mt = 0; mt < 4; ++mt)
#pragma unroll
                    for (int r = 0; r < 16; ++r) memVT[((size_t)(b * 1024 + c.f0 - 1024 + c.wm * 128 + mt * 32 + crow(r, c.hh)) << 8) + key] = f2bf(acc[mt][nt][r] * rs); }
        }
    }
};

struct EpiFfn {
    static constexpr bool FULL = true;
    bf16_t* act; const float *cw, *cb; int sbase, S, pos0, ft;
    __device__ __forceinline__ void operator()(f32x16 (&acc)[4][2], const TileCtx& c, char* lds) const {
        float* U = (float*)lds;
        const int tid = otid(), f = tid & 63, tq = tid >> 6;
#pragma unroll
        for (int ps = 0; ps < 2; ++ps) {
#pragma unroll
            for (int nt = 0; nt < 2; ++nt) { const int tl = c.wn * 64 + nt * 32 + c.l31; const float rs = ((unsigned)(pos0 + tl) < (unsigned)S) ? c.rs[nt] : 0.f;
#pragma unroll
                for (int mt = 0; mt < 2; ++mt)
#pragma unroll
                    for (int r = 0; r < 16; ++r) U[tl * 129 + c.wm * 64 + mt * 32 + crow(r, c.hh)] = acc[2 * ps + mt][nt][r] * rs; }
            RAW_BARRIER();
            { const int fa = ft * 128 + ps * 64 + f, fg = 2816 + fa;
              const float a0 = cw[fa], a1 = cw[5632 + fa], a2 = cw[2 * 5632 + fa], ab = cb[fa], g0 = cw[fg], g1 = cw[5632 + fg], g2 = cw[2 * 5632 + fg], gb = cb[fg];
              const int i0 = 1 + tq * 32; int i1 = i0 + 32; if (i1 > 255) i1 = 255;
              float pa = U[(i0 - 1) * 129 + f], ca = U[i0 * 129 + f], pg = U[(i0 - 1) * 129 + 64 + f], cg_ = U[i0 * 129 + 64 + f];
              const float* up = U + (i0 + 1) * 129 + f; bf16_t* ap = act + (size_t)(sbase + pos0 + i0) * 2816 + fa; int lim = S - (pos0 + i0); lim = lim < i1 - i0 ? lim : i1 - i0;
              for (int i = 0; i < lim; ++i) { const float na = up[0], ng = up[64]; up += 129;
                  const float ua = a0 * pa + a1 * ca + a2 * na + ab, ug = g0 * pg + g1 * cg_ + g2 * ng + gb;
                  const float y = ua * ug * __builtin_amdgcn_rcpf(1.f + __builtin_amdgcn_exp2f(-1.4426950408889634f * ug));
                  *ap = f2bf(y); ap += 2816;
                  pa = ca; ca = na; pg = cg_; cg_ = ng; } }
            RAW_BARRIER();
        }
    }
};

template <int NKS, int NDT, class Hook>
__device__ __forceinline__ void attn_wave(const bf16_t* __restrict__ qrow, const bf16_t* __restrict__ kb, const int kstride, const bf16_t* __restrict__ vT, const size_t vstride,
                                          const int sub_lo, const int sub_hi, Hook& hook, f32x16 (&O)[NDT], float& m_out, float& l_out) {
    const int lane = otid() & 63, l31 = lane & 31, hh = lane >> 5;
    bf16x8 qf[NKS];
#pragma unroll
    for (int ks = 0; ks < NKS; ++ks) qf[ks] = *(const bf16x8*)(qrow + ks * 16 + hh * 8);
    float m = -1e30f, lsum = 0.f;
#pragma unroll
    for (int dt = 0; dt < NDT; ++dt)
#pragma unroll
        for (int r = 0; r < 16; ++r) O[dt][r] = 0.f;
    bf16x8 kn[NKS]; s16x4 vn[NDT][4]; float bn[16];
#define AW_LOAD(sub_) do { const bf16_t* kp_ = kb + (size_t)((sub_) * 32 + l31) * kstride + hh * 8;                                        \
        _Pragma("unroll") for (int ks = 0; ks < NKS; ++ks) kn[ks] = *(const bf16x8*)(kp_ + ks * 16);                                       \
        _Pragma("unroll") for (int dt = 0; dt < NDT; ++dt) { const bf16_t* vp_ = vT + (size_t)(dt * 32 + l31) * vstride + (sub_) * 32 + hh * 4; \
            vn[dt][0] = *(const s16x4*)vp_; vn[dt][1] = *(const s16x4*)(vp_ + 8); vn[dt][2] = *(const s16x4*)(vp_ + 16); vn[dt][3] = *(const s16x4*)(vp_ + 24); } \
        hook.load(bn, (sub_)); } while (0)
    AW_LOAD(sub_lo);
    for (int sub = sub_lo; sub < sub_hi; ++sub) {
        bf16x8 kc[NKS]; s16x4 vc[NDT][4]; float bc[16];
#pragma unroll
        for (int ks = 0; ks < NKS; ++ks) kc[ks] = kn[ks];
#pragma unroll
        for (int dt = 0; dt < NDT; ++dt)
#pragma unroll
            for (int i = 0; i < 4; ++i) vc[dt][i] = vn[dt][i];
#pragma unroll
        for (int r = 0; r < 16; ++r) bc[r] = bn[r];
        if (sub + 1 < sub_hi) AW_LOAD(sub + 1);
        f32x16 s;
#pragma unroll
        for (int r = 0; r < 16; ++r) s[r] = 0.f;
#pragma unroll
        for (int ks = 0; ks < NKS; ++ks) s = MFMA32(kc[ks], qf[ks], s);
        hook.apply(s, sub, bc);
        float mx = s[0];
#pragma unroll
        for (int r = 1; r < 16; ++r) mx = fmaxf(mx, s[r]);
        mx = fmaxf(mx, __shfl_xor(mx, 32));
        const float mn = fmaxf(m, mx), alpha = __builtin_amdgcn_exp2f(m - mn); m = mn;
        float ps = 0.f;
#pragma unroll
        for (int r = 0; r < 16; ++r) { s[r] = __builtin_amdgcn_exp2f(s[r] - mn); ps += s[r]; }
        lsum = lsum * alpha + ps;
        u32x4 w0 = {pk2(s[0], s[1]), pk2(s[2], s[3]), pk2(s[4], s[5]), pk2(s[6], s[7])}, w1 = {pk2(s[8], s[9]), pk2(s[10], s[11]), pk2(s[12], s[13]), pk2(s[14], s[15])};
        const bf16x8 pf0 = *(bf16x8*)&w0, pf1 = *(bf16x8*)&w1;
#pragma unroll
        for (int dt = 0; dt < NDT; ++dt) {
#pragma unroll
            for (int r = 0; r < 16; ++r) O[dt][r] *= alpha;
            const bf16x8 va = {vc[dt][0][0], vc[dt][0][1], vc[dt][0][2], vc[dt][0][3], vc[dt][1][0], vc[dt][1][1], vc[dt][1][2], vc[dt][1][3]},
                         vb = {vc[dt][2][0], vc[dt][2][1], vc[dt][2][2], vc[dt][2][3], vc[dt][3][0], vc[dt][3][1], vc[dt][3][2], vc[dt][3][3]};
            O[dt] = MFMA32(va, pf0, O[dt]); O[dt] = MFMA32(vb, pf1, O[dt]);
        }
    }
#undef AW_LOAD
    l_out = lsum + __shfl_xor(lsum, 32); m_out = m;
}
template <int NDT>
__device__ __forceinline__ void attn_store(bf16_t* orow, const f32x16 (&O)[NDT], float l) {
    const int hh = (otid() & 63) >> 5; const float inv = 1.f / l;
#pragma unroll
    for (int dt = 0; dt < NDT; ++dt)
#pragma unroll
        for (int g = 0; g < 4; ++g) st4(orow + dt * 32 + 8 * g + 4 * hh, O[dt][4 * g] * inv, O[dt][4 * g + 1] * inv, O[dt][4 * g + 2] * inv, O[dt][4 * g + 3] * inv);
}

struct HookNA { const float* rpb; int c, cs, joff, hh;
    __device__ __forceinline__ void load(float (&b)[16], int sub) const { const int j = sub >> 1, cb = (sub & 1) * 32; const float* row = rpb + (joff + j) * 31 + 15 - c;
#pragma unroll
        for (int r = 0; r < 16; ++r) { const int col = cb + crow(r, hh); b[r] = ((unsigned)(col - cs) < 16u) ? row[col] : -1e30f; } }
    __device__ __forceinline__ void apply(f32x16& s, int, const float (&b)[16]) const {
#pragma unroll
        for (int r = 0; r < 16; ++r) s[r] = b[r] > -1e29f ? (s[r] * 0.125f + b[r]) * LOG2E : -1e30f; } };
struct HookDil { int qv, hh;
    __device__ __forceinline__ void load(float (&)[16], int) const {}
    __device__ __forceinline__ void apply(f32x16& s, int sub, const float (&)[16]) const {
#pragma unroll
        for (int r = 0; r < 16; ++r) { int d = sub * 32 + crow(r, hh) - qv; d = d < 0 ? -d : d; s[r] = d <= 64 ? s[r] * (0.125f * LOG2E) : -1e30f; } } };

#define PK4(P, BASE, OUT) do { const unsigned a0_ = pk2(P[BASE + 0], P[BASE + 1]), a1_ = pk2(P[BASE + 2], P[BASE + 3]), b0_ = pk2(P[BASE + 4], P[BASE + 5]), b1_ = pk2(P[BASE + 6], P[BASE + 7]); \
        const auto r0_ = __builtin_amdgcn_permlane32_swap(a0_, b0_, false, false); const auto r1_ = __builtin_amdgcn_permlane32_swap(a1_, b1_, false, false);                              \
        u32x4 w_ = {r0_[0], r1_[0], r0_[1], r1_[1]}; OUT = *(bf16x8*)&w_; } while (0)
__device__ __forceinline__ void dense_item(bf16_t* qrow, const bf16_t* __restrict__ kb, const bf16_t* __restrict__ vT, const int nt, const float sc, char* lds) {
    const int tid = otid(), lane = tid & 63, wid = tid >> 6, l31 = lane & 31, hh = lane >> 5;
    int off[3];
#pragma unroll
    for (int j = 0; j < 3; ++j) { const int pc = wid + 8 * j;
        if (pc < 12) { const int b = pc * 1024 + lane * 16, r = b / 192, cp = (b - r * 192) >> 4, c = (cp & ~3) | ((cp & 3) ^ ((r >> 2) & 3)); off[j] = r * 576 + c * 8; }
        else { const int r = (pc - 12) * 8 + (lane >> 3), p = (lane & 7) ^ ((r >> 1) & 7); off[j] = r * TP + p * 8; } }
    const bool three = wid < 4;
#define DPIECE(j_, st_, t_) do { const int pc_ = wid + 8 * (j_); const bf16_t* g_ = pc_ < 12 ? kb + (size_t)(t_) * (64 * 576) + off[j_] : vT + (t_) * 64 + off[j_]; GLDS(g_, lds + (st_) * 20480 + pc_ * 1024); } while (0)
#define DSTAGE(st_, t_) do { DPIECE(0, st_, t_); DPIECE(1, st_, t_); if (three) DPIECE(2, st_, t_); } while (0)
#define DWAIT1() do { if (three) WAIT_V(3); else WAIT_V(2); } while (0)
#define DWAIT2() do { if (three) WAIT_V(6); else WAIT_V(4); } while (0)
    DSTAGE(0, 0); if (nt > 1) DSTAGE(1, 1); if (nt > 2) DSTAGE(2, 2);
    bf16x8 qf[6];
#pragma unroll
    for (int ks = 0; ks < 6; ++ks) qf[ks] = *(const bf16x8*)(qrow + ks * 16 + hh * 8);
    const int x = (l31 >> 2) & 3, y = (l31 >> 1) & 7;
    int kfo[6], vfo[4];
#pragma unroll
    for (int ks = 0; ks < 6; ++ks) { const int c = 2 * ks + hh; kfo[ks] = l31 * 192 + (((c & ~3) | ((c & 3) ^ x)) << 4); }
#pragma unroll
    for (int pp = 0; pp < 4; ++pp) vfo[pp] = 12288 + l31 * 128 + (((2 * pp + hh) ^ y) << 4);
    float m = -1e30f, lsum = 0.f; f32x16 O0, O1, s0, s1;
#pragma unroll
    for (int r = 0; r < 16; ++r) { O0[r] = 0.f; O1[r] = 0.f; s0[r] = 0.f; s1[r] = 0.f; }
    if (nt > 2) DWAIT2(); else if (nt > 1) DWAIT1(); else WAIT_V(0);
    RAW_BARRIER();
#pragma unroll
    for (int ks = 0; ks < 6; ++ks) { s0 = MFMA32(*(const bf16x8*)(lds + kfo[ks]), qf[ks], s0); s1 = MFMA32(*(const bf16x8*)(lds + kfo[ks] + 6144), qf[ks], s1); }
#define SNEXT(ks_, m_) do { if (m_) { n0 = MFMA32(*(const bf16x8*)(sn + kfo[ks_]), qf[ks_], n0); n1 = MFMA32(*(const bf16x8*)(sn + kfo[ks_] + 6144), qf[ks_], n1); } } while (0)
#define TILE_BODY(MORE_) do { \
        const char* sb = lds + (t & 3) * 20480; const char* sn = lds + ((t + 1) & 3) * 20480; \
        f32x16 n0, n1; \
_Pragma("unroll")         for (int r = 0; r < 16; ++r) { n0[r] = 0.f; n1[r] = 0.f; } \
        SNEXT(0, MORE_); \
        float mx = s0[0]; \
_Pragma("unroll")         for (int r = 0; r < 8; ++r) mx = vmax3(mx, s0[r], s1[r]); \
        SNEXT(1, MORE_); \
_Pragma("unroll")         for (int r = 8; r < 16; ++r) mx = vmax3(mx, s0[r], s1[r]); \
        mx = fmaxf(mx, __shfl_xor(mx, 32)) * sc; \
        const float mn = fmaxf(m, mx), alpha = __builtin_amdgcn_exp2f(m - mn); m = mn; \
        SNEXT(2, MORE_); \
        float ps = 0.f; \
_Pragma("unroll")         for (int r = 0; r < 8; ++r) { s0[r] = __builtin_amdgcn_exp2f(fmaf(s0[r], sc, -mn)); s1[r] = __builtin_amdgcn_exp2f(fmaf(s1[r], sc, -mn)); ps += s0[r] + s1[r]; } \
        SNEXT(3, MORE_); \
_Pragma("unroll")         for (int r = 8; r < 16; ++r) { s0[r] = __builtin_amdgcn_exp2f(fmaf(s0[r], sc, -mn)); s1[r] = __builtin_amdgcn_exp2f(fmaf(s1[r], sc, -mn)); ps += s0[r] + s1[r]; } \
        lsum = lsum * alpha + ps; \
        SNEXT(4, MORE_); \
        bf16x8 pf0, pf1, pf2, pf3; PK4(s0, 0, pf0); PK4(s0, 8, pf1); \
        SNEXT(5, MORE_); \
        PK4(s1, 0, pf2); PK4(s1, 8, pf3); \
_Pragma("unroll")         for (int r = 0; r < 16; ++r) { O0[r] *= alpha; O1[r] *= alpha; } \
        O0 = MFMA32(*(const bf16x8*)(sb + vfo[0]), pf0, O0); O1 = MFMA32(*(const bf16x8*)(sb + vfo[0] + 4096), pf0, O1); \
        O0 = MFMA32(*(const bf16x8*)(sb + vfo[1]), pf1, O0); O1 = MFMA32(*(const bf16x8*)(sb + vfo[1] + 4096), pf1, O1); \
        O0 = MFMA32(*(const bf16x8*)(sb + vfo[2]), pf2, O0); O1 = MFMA32(*(const bf16x8*)(sb + vfo[2] + 4096), pf2, O1); \
        O0 = MFMA32(*(const bf16x8*)(sb + vfo[3]), pf3, O0); O1 = MFMA32(*(const bf16x8*)(sb + vfo[3] + 4096), pf3, O1); \
        s0 = n0; s1 = n1; } while (0)
    for (int t = 0; t + 1 < nt; ++t) {
        if (t + 2 < nt) DWAIT1(); else WAIT_V(0);
        RAW_BARRIER();
        if (t + 3 < nt) DSTAGE((t + 3) & 3, t + 3);
        TILE_BODY(true);
    }
    { const int t = nt - 1; TILE_BODY(false); }
#undef TILE_BODY
#undef SNEXT
#undef DSTAGE
#undef DPIECE
#undef DWAIT1
#undef DWAIT2
    RAW_BARRIER();
    const float inv = 1.f / (lsum + __shfl_xor(lsum, 32));
#pragma unroll
    for (int g = 0; g < 4; ++g) { st4(qrow + 8 * g + 4 * hh, O0[4 * g] * inv, O0[4 * g + 1] * inv, O0[4 * g + 2] * inv, O0[4 * g + 3] * inv);
        st4(qrow + 32 + 8 * g + 4 * hh, O1[4 * g] * inv, O1[4 * g + 1] * inv, O1[4 * g + 2] * inv, O1[4 * g + 3] * inv); }
}

__device__ __forceinline__ void na_item(bf16_t* naq, const bf16_t* __restrict__ nak, const bf16_t* __restrict__ navT, const float* __restrict__ rpbh, const int tR0, const int head, char* lds) {
    const int tid = otid(), lane = tid & 63, wid = tid >> 6, l31 = lane & 31, hh = lane >> 5;
    int sbase, S; tokinfo(tR0, sbase, S); const int rows = S >> 6, r0 = (tR0 - sbase) >> 6;
    int rs0 = r0 - 4; rs0 = rs0 < 0 ? 0 : rs0; rs0 = rs0 > rows - 8 ? rows - 8 : rs0;
    int rs3 = r0 - 1; rs3 = rs3 < 0 ? 0 : rs3; rs3 = rs3 > rows - 8 ? rows - 8 : rs3;
    const int nch = rs3 - rs0 + 8, ri = r0 + (wid >> 1);
    int rsi = ri - 4; rsi = rsi < 0 ? 0 : rsi; rsi = rsi > rows - 8 ? rows - 8 : rsi;
    const int jlo = __builtin_amdgcn_readfirstlane(rsi - rs0);
    const int c = (wid & 1) * 32 + l31; int cs = c - 8; cs = cs < 0 ? 0 : cs; cs = cs > 48 ? 48 : cs;
    const int sr = 8 * wid + (lane >> 3), sc8 = ((lane & 7) ^ ((sr >> 1) & 7)) * 8;
    const bf16_t* ksrc = nak + (size_t)(sbase + rs0 * 64 + sr) * 384 + head * 64 + sc8;
    const bf16_t* vsrc = navT + (size_t)(head * 64 + sr) * TP + sbase + rs0 * 64 + sc8;
#define NSTAGE(slot_, j_) do { GLDS(ksrc + (size_t)(j_) * (64 * 384), lds + (slot_) * 16384 + wid * 1024); GLDS(vsrc + (j_) * 64, lds + (slot_) * 16384 + 8192 + wid * 1024); } while (0)
    float* tab = (float*)(lds + 65536);
    if (tid < 465) tab[tid] = rpbh[tid];
    NSTAGE(0, 0); NSTAGE(1, 1); NSTAGE(2, 2);
    bf16_t* qrow = naq + (size_t)(tR0 + (wid >> 1) * 64 + c) * 384 + head * 64;
    bf16x8 qf[4];
#pragma unroll
    for (int ks = 0; ks < 4; ++ks) qf[ks] = *(const bf16x8*)(qrow + ks * 16 + hh * 8);
    const int y = (l31 >> 1) & 7;
    int fo[4];
#pragma unroll
    for (int k = 0; k < 4; ++k) fo[k] = l31 * 128 + (((2 * k + hh) ^ y) << 4);
    float m = -1e30f, lsum = 0.f; f32x16 O0, O1;
#pragma unroll
    for (int r = 0; r < 16; ++r) { O0[r] = 0.f; O1[r] = 0.f; }
    for (int j = 0; j < nch; ++j) {
        if (j + 2 < nch) WAIT_V(4); else if (j + 1 < nch) WAIT_V(2); else WAIT_V(0);
        RAW_BARRIER();
        if (j + 3 < nch) NSTAGE((j + 3) & 3, j + 3);
        if (j >= jlo && j < jlo + 8) {
            const char* sb = lds + (j & 3) * 16384;
            f32x16 s0, s1;
#pragma unroll
            for (int r = 0; r < 16; ++r) { s0[r] = 0.f; s1[r] = 0.f; }
#pragma unroll
            for (int ks = 0; ks < 4; ++ks) { s0 = MFMA32(*(const bf16x8*)(sb + fo[ks]), qf[ks], s0); s1 = MFMA32(*(const bf16x8*)(sb + fo[ks] + 4096), qf[ks], s1); }
            const int base = (rs0 + j - ri + 7) * 31 + 15 - c;
#pragma unroll
            for (int r = 0; r < 16; ++r) { const int c0 = crow(r, hh), c1 = 32 + c0; const bool v0 = (unsigned)(c0 - cs) < 16u, v1 = (unsigned)(c1 - cs) < 16u;
                const float b0 = tab[v0 ? base + c0 : 0], b1 = tab[v1 ? base + c1 : 0];
                s0[r] = v0 ? (s0[r] * 0.125f + b0) * LOG2E : -1e30f; s1[r] = v1 ? (s1[r] * 0.125f + b1) * LOG2E : -1e30f; }
            float mx = s0[0];
#pragma unroll
            for (int r = 0; r < 16; ++r) mx = vmax3(mx, s0[r], s1[r]);
            mx = fmaxf(mx, __shfl_xor(mx, 32));
            const float mn = fmaxf(m, mx), alpha = __builtin_amdgcn_exp2f(m - mn); m = mn;
            float ps = 0.f;
#pragma unroll
            for (int r = 0; r < 16; ++r) { s0[r] = __builtin_amdgcn_exp2f(s0[r] - mn); s1[r] = __builtin_amdgcn_exp2f(s1[r] - mn); ps += s0[r] + s1[r]; }
            lsum = lsum * alpha + ps;
            bf16x8 pf0, pf1, pf2, pf3; PK4(s0, 0, pf0); PK4(s0, 8, pf1); PK4(s1, 0, pf2); PK4(s1, 8, pf3);
#pragma unroll
            for (int r = 0; r < 16; ++r) { O0[r] *= alpha; O1[r] *= alpha; }
            const char* sv = sb + 8192;
            O0 = MFMA32(*(const bf16x8*)(sv + fo[0]), pf0, O0); O1 = MFMA32(*(const bf16x8*)(sv + fo[0] + 4096), pf0, O1);
            O0 = MFMA32(*(const bf16x8*)(sv + fo[1]), pf1, O0); O1 = MFMA32(*(const bf16x8*)(sv + fo[1] + 4096), pf1, O1);
            O0 = MFMA32(*(const bf16x8*)(sv + fo[2]), pf2, O0); O1 = MFMA32(*(const bf16x8*)(sv + fo[2] + 4096), pf2, O1);
            O0 = MFMA32(*(const bf16x8*)(sv + fo[3]), pf3, O0); O1 = MFMA32(*(const bf16x8*)(sv + fo[3] + 4096), pf3, O1);
        }
    }
#undef NSTAGE
    RAW_BARRIER();
    const float inv = 1.f / (lsum + __shfl_xor(lsum, 32));
#pragma unroll
    for (int g = 0; g < 4; ++g) { st4(qrow + 8 * g + 4 * hh, O0[4 * g] * inv, O0[4 * g + 1] * inv, O0[4 * g + 2] * inv, O0[4 * g + 3] * inv);
        st4(qrow + 32 + 8 * g + 4 * hh, O1[4 * g] * inv, O1[4 * g + 1] * inv, O1[4 * g + 2] * inv, O1[4 * g + 3] * inv); }
}

__device__ __forceinline__ void dil_item(bf16_t* dq, const bf16_t* __restrict__ dk, const bf16_t* __restrict__ dvT, float* lse, const int tp0, const int h12, char* lds) {
    const int tid = otid(), lane = tid & 63, wid = tid >> 6, l31 = lane & 31, hh = lane >> 5, g = h12 >> 2;
    int sbase, S; tokinfo(tp0, sbase, S); const int L = S >> (2 * g);
    const int tpw = tp0 + 32 * wid, rho = (tpw - sbase) / L, vsb = sbase + rho * L, cb = tp0 - 64;
    const int sr = 8 * wid + (lane >> 3), sc8 = ((lane & 7) ^ ((sr >> 1) & 7)) * 8;
#define DLSTAGE(slot_, j_) do { int cj_ = cb + 64 * (j_); cj_ = cj_ < 0 ? 0 : (cj_ > T - 64 ? T - 64 : cj_);                                                        \
        GLDS(dk + (size_t)(cj_ + sr) * 768 + h12 * 64 + sc8, lds + (slot_) * 16384 + wid * 1024);                                                                    \
        GLDS(dvT + (size_t)(h12 * 64 + sr) * TP + cj_ + sc8, lds + (slot_) * 16384 + 8192 + wid * 1024); } while (0)
    DLSTAGE(0, 0); DLSTAGE(1, 1); DLSTAGE(2, 2);
    bf16_t* qrow = dq + (size_t)(tpw + l31) * 768 + h12 * 64;
    bf16x8 qf[4];
#pragma unroll
    for (int ks = 0; ks < 4; ++ks) qf[ks] = *(const bf16x8*)(qrow + ks * 16 + hh * 8);
    const int y = (l31 >> 1) & 7, qp = tpw + l31, jlo = __builtin_amdgcn_readfirstlane(wid >> 1);
    int fo[4];
#pragma unroll
    for (int k = 0; k < 4; ++k) fo[k] = l31 * 128 + (((2 * k + hh) ^ y) << 4);
    float m = -1e30f, lsum = 0.f; f32x16 O0, O1;
#pragma unroll
    for (int r = 0; r < 16; ++r) { O0[r] = 0.f; O1[r] = 0.f; }
    for (int j = 0; j < 6; ++j) {
        if (j + 2 < 6) WAIT_V(4); else if (j + 1 < 6) WAIT_V(2); else WAIT_V(0);
        RAW_BARRIER();
        if (j + 3 < 6) DLSTAGE((j + 3) & 3, j + 3);
        const int kb0 = __builtin_amdgcn_readfirstlane(cb + 64 * j);
        if (j >= jlo && j <= jlo + 2 && kb0 + 64 > vsb && kb0 < vsb + L) {
            const char* sb = lds + (j & 3) * 16384;
            f32x16 s0, s1;
#pragma unroll
            for (int r = 0; r < 16; ++r) { s0[r] = 0.f; s1[r] = 0.f; }
#pragma unroll
            for (int ks = 0; ks < 4; ++ks) { s0 = MFMA32(*(const bf16x8*)(sb + fo[ks]), qf[ks], s0); s1 = MFMA32(*(const bf16x8*)(sb + fo[ks] + 4096), qf[ks], s1); }
#pragma unroll
            for (int r = 0; r < 16; ++r) { const int k0 = kb0 + crow(r, hh), k1 = k0 + 32; int d0 = k0 - qp, d1 = k1 - qp; d0 = d0 < 0 ? -d0 : d0; d1 = d1 < 0 ? -d1 : d1;
                s0[r] = (d0 <= 64 && k0 >= vsb && k0 < vsb + L) ? s0[r] * (0.125f * LOG2E) : -1e30f; s1[r] = (d1 <= 64 && k1 >= vsb && k1 < vsb + L) ? s1[r] * (0.125f * LOG2E) : -1e30f; }
            float mx = s0[0];
#pragma unroll
            for (int r = 0; r < 16; ++r) mx = vmax3(mx, s0[r], s1[r]);
            mx = fmaxf(mx, __shfl_xor(mx, 32));
            const float mn = fmaxf(m, mx), alpha = __builtin_amdgcn_exp2f(m - mn); m = mn;
            float ps = 0.f;
#pragma unroll
            for (int r = 0; r < 16; ++r) { s0[r] = __builtin_amdgcn_exp2f(s0[r] - mn); s1[r] = __builtin_amdgcn_exp2f(s1[r] - mn); ps += s0[r] + s1[r]; }
            lsum = lsum * alpha + ps;
            bf16x8 pf0, pf1, pf2, pf3; PK4(s0, 0, pf0); PK4(s0, 8, pf1); PK4(s1, 0, pf2); PK4(s1, 8, pf3);
#pragma unroll
            for (int r = 0; r < 16; ++r) { O0[r] *= alpha; O1[r] *= alpha; }
            const char* sv = sb + 8192;
            O0 = MFMA32(*(const bf16x8*)(sv + fo[0]), pf0, O0); O1 = MFMA32(*(const bf16x8*)(sv + fo[0] + 4096), pf0, O1);
            O0 = MFMA32(*(const bf16x8*)(sv + fo[1]), pf1, O0); O1 = MFMA32(*(const bf16x8*)(sv + fo[1] + 4096), pf1, O1);
            O0 = MFMA32(*(const bf16x8*)(sv + fo[2]), pf2, O0); O1 = MFMA32(*(const bf16x8*)(sv + fo[2] + 4096), pf2, O1);
            O0 = MFMA32(*(const bf16x8*)(sv + fo[3]), pf3, O0); O1 = MFMA32(*(const bf16x8*)(sv + fo[3] + 4096), pf3, O1);
        }
    }
#undef DLSTAGE
    RAW_BARRIER();
    const float ltot = lsum + __shfl_xor(lsum, 32), inv = 1.f / ltot;
#pragma unroll
    for (int gq = 0; gq < 4; ++gq) { st4(qrow + 8 * gq + 4 * hh, O0[4 * gq] * inv, O0[4 * gq + 1] * inv, O0[4 * gq + 2] * inv, O0[4 * gq + 3] * inv);
        st4(qrow + 32 + 8 * gq + 4 * hh, O1[4 * gq] * inv, O1[4 * gq + 1] * inv, O1[4 * gq + 2] * inv, O1[4 * gq + 3] * inv); }
    if (hh == 0) { const int tn = sbase + ((qp - vsb) << (2 * g)) + rho; lse[(size_t)tn * 12 + h12] = (m + __log2f(ltot)) * 0.6931471805599453f; }
}

__device__ __forceinline__ void cross_item(const bf16_t* __restrict__ kh, const bf16_t* __restrict__ vh, bf16_t* orow, char* lds) {
    const int tid = otid(), lane = tid & 63, wid = tid >> 6, l31 = lane & 31, hh = lane >> 5;
    int offK[2], offV[2];
#pragma unroll
    for (int j = 0; j < 2; ++j) { const int pc = wid + 8 * j, r = 2 * pc + (lane >> 5), c = (lane & 31) ^ (r & 15); offK[j] = r * 1024 + c * 8; offV[j] = r * 256 + c * 8; }
#define XSTAGE(slot_, ch_) do { _Pragma("unroll") for (int j_ = 0; j_ < 2; ++j_) { const bf16_t* g_ = (ch_) < 8 ? kh + (size_t)(ch_) * (32 * 1024) + offK[j_] : vh + (size_t)((ch_) - 8) * (32 * 256) + offV[j_];   \
            GLDS(g_, lds + (slot_) * 16384 + (wid + 8 * j_) * 1024); } } while (0)
    bf16x8 qf[16]; float a = 0.f;
    { const int row = wid * 32 + l31; const char* qb = lds + row * 512;
#pragma unroll
      for (int ks = 0; ks < 16; ++ks) { qf[ks] = *(const bf16x8*)(qb + (((2 * ks + hh) ^ (row & 15)) << 4));
#pragma unroll
        for (int e = 0; e < 8; ++e) { const float v = __uint_as_float(((unsigned)(unsigned short)qf[ks][e]) << 16); a += v * v; } } }
    a += __shfl_xor(a, 32); const float rq = rsqrtf(a * (1.f / 256.f) + EPS) * LOG2E;
    RAW_BARRIER();
    XSTAGE(0, 0); XSTAGE(1, 1); XSTAGE(2, 2);
    const int x = l31 & 15, fb = l31 * 512;
    f32x16 s[8]; bf16x8 pf[16]; float linv = 0.f;
#pragma unroll
    for (int ch = 0; ch < 16; ++ch) {
        if (ch + 2 < 16) WAIT_V(4); else if (ch + 1 < 16) WAIT_V(2); else WAIT_V(0);
        RAW_BARRIER();
        if (ch + 3 < 16) XSTAGE((ch + 3) & 3, ch + 3);
        const char* sb = lds + (ch & 3) * 16384 + fb;
        if (ch < 8) {
#pragma unroll
            for (int r = 0; r < 16; ++r) s[ch][r] = 0.f;
#pragma unroll
            for (int ks = 0; ks < 16; ++ks) s[ch] = MFMA32(*(const bf16x8*)(sb + (((2 * ks + hh) ^ x) << 4)), qf[ks], s[ch]);
        } else {
            if (ch == 8) { float mx = s[0][0];
#pragma unroll
                for (int i = 0; i < 8; ++i)
#pragma unroll
                    for (int r = 0; r < 16; r += 2) mx = vmax3(mx, s[i][r], s[i][r + 1]);
                mx = fmaxf(mx, __shfl_xor(mx, 32)) * rq; float ps = 0.f;
#pragma unroll
                for (int i = 0; i < 8; ++i) {
#pragma unroll
                    for (int r = 0; r < 16; ++r) { s[i][r] = __builtin_amdgcn_exp2f(fmaf(s[i][r], rq, -mx)); ps += s[i][r]; }
                    PK4(s[i], 0, pf[2 * i]); PK4(s[i], 8, pf[2 * i + 1]); }
                linv = 1.f / (ps + __shfl_xor(ps, 32)); }
            f32x16 O;
#pragma unroll
            for (int r = 0; r < 16; ++r) O[r] = 0.f;
#pragma unroll
            for (int ks = 0; ks < 16; ++ks) O = MFMA32(*(const bf16x8*)(sb + (((2 * ks + hh) ^ x) << 4)), pf[ks], O);
#pragma unroll
            for (int g = 0; g < 4; ++g) st4(orow + (ch - 8) * 32 + 8 * g + 4 * hh, O[4 * g] * linv, O[4 * g + 1] * linv, O[4 * g + 2] * linv, O[4 * g + 3] * linv);
        }
    }
#undef XSTAGE
    RAW_BARRIER();
}

__device__ __forceinline__ SrcX xsrc(const P& p, int l, bool after_mix) {
    SrcX s; if (l == 0 && !after_mix) { s.p0 = p.xp; s.p1 = p.xs - (size_t)NPR * 1024; s.split = NPR; } else { s.p0 = p.out; s.p1 = p.out; s.split = T; } return s;
}
__device__ __forceinline__ SrcXb xbsrc(char* ws) { SrcXb s; s.xb = (const bf16_t*)(ws + OFF_XB); s.ssp = (const float*)(ws + OFF_SSP); return s; }
__device__ __forceinline__ EpiRes epires(const P& p, char* ws, int l, bool after_mix) {
    EpiRes e; e.xin = xsrc(p, l, after_mix); e.out = p.out; e.xb = (bf16_t*)(ws + OFF_XB); e.ssp = (float*)(ws + OFF_SSP); return e;
}
__device__ __forceinline__ void rowcvt(const float* src, bf16_t* dst, float* ssp16, int lane) {
    const float* s = src + lane * 16; const f32x4 a = *(const f32x4*)s, b = *(const f32x4*)(s + 4), c = *(const f32x4*)(s + 8), d = *(const f32x4*)(s + 12);
    float ss = a[0] * a[0] + a[1] * a[1] + a[2] * a[2] + a[3] * a[3] + b[0] * b[0] + b[1] * b[1] + b[2] * b[2] + b[3] * b[3]
             + c[0] * c[0] + c[1] * c[1] + c[2] * c[2] + c[3] * c[3] + d[0] * d[0] + d[1] * d[1] + d[2] * d[2] + d[3] * d[3];
    u32x4 w0 = {pk2(a[0], a[1]), pk2(a[2], a[3]), pk2(b[0], b[1]), pk2(b[2], b[3])}, w1 = {pk2(c[0], c[1]), pk2(c[2], c[3]), pk2(d[0], d[1]), pk2(d[2], d[3])};
    *(u32x4*)(dst + lane * 16) = w0; *(u32x4*)(dst + lane * 16 + 8) = w1;
    ss += __shfl_xor(ss, 1); ss += __shfl_xor(ss, 2); if ((lane & 3) == 0) ssp16[lane >> 2] = ss;
}

__device__ void phase0(const P& p, char* lds) {
    constexpr unsigned mask = (1u << W_NUM) - 1;
    const int ncv = cvt_count(mask), nrope = 8192 * 48 / 512, nxr = T / 8, nmr = 2560 / 8;
    char* ws = ows(p.ws); const int tid = otid();
    if (blockIdx.x == 0 && tid < 64) ((unsigned*)(ws + OFF_CTR))[tid] = 0u;
    for (int it = blockIdx.x; it < ncv + nrope + nxr + nmr; it += gridDim.x) {
        if (it < ncv) cvt_item(p, 0, mask, it, lds);
        else if (it < ncv + nrope) { const int idx = (it - ncv) * 512 + tid; int pos, i; float inv; f32x2* dst;
            if (idx < 8192 * 32) { pos = idx >> 5; i = idx & 31; inv = p.inv32[i]; dst = (f32x2*)(ws + OFF_ROPE32) + idx; }
            else { const int k = idx - 8192 * 32; pos = k >> 4; i = k & 15; inv = p.inv16[i]; dst = (f32x2*)(ws + OFF_ROPE16) + k; }
            const float ang = (float)pos * inv; const double tr = (double)ang * 0.15915494309189535; const float fr = (float)(tr - rint(tr));
            f32x2 cs = {__builtin_amdgcn_cosf(fr), __builtin_amdgcn_sinf(fr)}; *dst = cs; }
        else if (it < ncv + nrope + nxr) { const int t = (it - ncv - nrope) * 8 + (tid >> 6);
            rowcvt(t < NPR ? p.xp + (size_t)t * 1024 : p.xs + (size_t)(t - NPR) * 1024, (bf16_t*)(ws + OFF_XB) + (size_t)t * 1024, (float*)(ws + OFF_SSP) + (size_t)t * 16, tid & 63); }
        else { const int m = (it - ncv - nrope - nxr) * 8 + (tid >> 6);
            rowcvt(m < 2048 ? p.memp + (size_t)m * 1024 : p.mems + (size_t)(m - 2048) * 1024, (bf16_t*)(ws + OFF_MEMB) + (size_t)m * 1024, (float*)(ws + OFF_MEMSSP) + (size_t)m * 16, tid & 63); }
    }
}

__device__ void phaseA(const P& p, int l, char* lds) {
    const int nin = swz_count(128, 16);
    char* ws = ows(p.ws);
    for (int it = blockIdx.x; it < nin; it += gridDim.x) { int mt, nt; if (!swz(it, 128, 16, mt, nt)) continue;
        EpiIn e; e.zc = (bf16_t*)(ws + OFF_ZC); e.naq = (bf16_t*)(ws + OFF_NAQ); e.nak = (bf16_t*)(ws + OFF_NAK); e.navT = (bf16_t*)(ws + OFF_NAVT);
        e.dq = (bf16_t*)(ws + OFF_DQ); e.dk = (bf16_t*)(ws + OFF_DK); e.dvT = (bf16_t*)(ws + OFF_DVT); e.zss = (float*)(ws + OFF_ZSS);
        e.na_qn = p.na_qn + l * 64; e.na_kn = p.na_kn + l * 64; e.dil_qn = p.dil_qn + l * 64; e.dil_kn = p.dil_kn + l * 64; e.rope32 = (const f32x2*)(ws + OFF_ROPE32);
        gemm_tile(xbsrc(ws), (const bf16_t*)(ws + OFF_WT_IN), 1024, nt * 256, mt * 256, 0, T, e, lds); }
}

__device__ void phaseB(const P& p, int l, char* lds, const int part = 0) {
    char* ws = ows(p.ws); const int nuq = swz_count(128, 3), nukv = swz_count(128, 3), nna = 768, ndil = 1536;
    const int tid_ = otid(), wid = tid_ >> 6, lane = tid_ & 63, l31 = lane & 31, hh = lane >> 5;
    unsigned* ctr = (unsigned*)(ws + OFF_CTR) + 4 + l; int* slot = (int*)(lds + LDS_BYTES - 16);
    for (;;) {
        if (tid_ == 0) *slot = (int)atomicAdd(ctr, 1u);
        RAW_BARRIER(); const int it0 = *slot; RAW_BARRIER();
        if (it0 >= nuq + nukv + nna + ndil) break;
        const int it = it0 < nna ? nuq + nukv + it0 : (it0 < nna + nuq + nukv ? it0 - nna : it0);
        if (it < nuq) { int mt, nt; if (!swz(it, 128, 3, mt, nt)) continue;
            SrcZ<4> s; s.p = (const bf16_t*)(ws + OFF_ZC); s.zss = (const float*)(ws + OFF_ZSS);
            EpiUq e; e.mq = (bf16_t*)(ws + OFF_MQ); e.qn = p.mla_qn + l * 96; e.rope16 = (const f32x2*)(ws + OFF_ROPE16);
            gemm_tile(s, (const bf16_t*)(ws + OFF_WT_UQ), 256, nt * 256, mt * 256, 0, T, e, lds); }
        else if (it < nuq + nukv) { int mt, nt; if (!swz(it - nuq, 128, 3, mt, nt)) continue;
            SrcZ<2> s; s.p = (const bf16_t*)(ws + OFF_ZC) + 256; s.zss = (const float*)(ws + OFF_ZSS) + 4;
            EpiUkv e; e.mk = (bf16_t*)(ws + OFF_MK); e.mvT = (bf16_t*)(ws + OFF_MVT); e.zc = (const bf16_t*)(ws + OFF_ZC); e.kn = p.mla_kn + l * 96; e.rope16 = (const f32x2*)(ws + OFF_ROPE16);
            gemm_tile(s, (const bf16_t*)(ws + OFF_WT_UKV), 128, nt * 256, mt * 256, 0, T, e, lds); }
        else if (it < nuq + nukv + nna) { const int bi = it - nuq - nukv, rg = bi / 6, head = bi - rg * 6;
            na_item((bf16_t*)(ws + OFF_NAQ), (const bf16_t*)(ws + OFF_NAK), (const bf16_t*)(ws + OFF_NAVT), p.na_rpb + ((size_t)l * 6 + head) * 465, rg * 256, head, lds); }
        else { const int bi = it - nuq - nukv - nna, h12 = bi >> 7, tp0 = (bi & 127) * 256;
            dil_item((bf16_t*)(ws + OFF_DQ), (const bf16_t*)(ws + OFF_DK), (const bf16_t*)(ws + OFF_DVT), (float*)(ws + OFF_LSE), tp0, h12, lds); }
    }
}

__device__ void phaseC(const P& p, int l, char* lds) {
    char* ws = ows(p.ws); const unsigned mask = l < 3 ? ((1u << W_IN) | (1u << W_UQ) | (1u << W_UK) | (1u << W_UV)) : 0u, mask2 = l > 0 ? ((1u << W_DOWN) | (1u << W_CO) | (1u << W_UP) | (1u << W_O) | (1u << W_CQ)) : 0u;
    const int ndense = 768, nmem = swz_count(10, 8), ncomb = 2048, ncv = cvt_count(mask), ncv2 = cvt_count(mask2);
    const int tid_ = otid(), wid = tid_ >> 6, lane = tid_ & 63, l31 = lane & 31;
    unsigned* ctr = (unsigned*)(ws + OFF_CTR) + l; int* slot = (int*)(lds + LDS_BYTES - 16);
    for (;;) {
        if (tid_ == 0) *slot = (int)atomicAdd(ctr, 1u);
        RAW_BARRIER(); const int it = *slot; RAW_BARRIER();
        if (it >= ndense + nmem + ncomb + ncv + ncv2) break;
        if (it < ndense) { int sbase, S, head, qb;
            if (it < 384) { const int sq = it / 192, rem = it - sq * 192; head = rem >> 5; qb = rem & 31; sbase = NPR + sq * 8192; S = 8192; }
            else { const int k = it - 384, sq = k / 48, rem = k - sq * 48; head = rem >> 3; qb = rem & 7; sbase = sq * 2048; S = 2048; }
            bf16_t* mq = (bf16_t*)(ws + OFF_MQ); bf16_t* qrow = mq + (size_t)(sbase + qb * 256 + wid * 32 + l31) * 576 + head * 96;
            dense_item(qrow, (const bf16_t*)(ws + OFF_MK) + (size_t)sbase * 576 + head * 96, (const bf16_t*)(ws + OFF_MVT) + (size_t)(head * 64) * TP + sbase, S >> 6, 0.10206207261596575f * LOG2E, lds); }
        else if (it < ndense + nmem) { int mt, nt; if (swz(it - ndense, 10, 8, mt, nt)) {
            SrcXb s; s.xb = (const bf16_t*)(ws + OFF_MEMB); s.ssp = (const float*)(ws + OFF_MEMSSP);
            EpiMem e; e.memK = (bf16_t*)(ws + OFF_MEMK); e.memVT = (bf16_t*)(ws + OFF_MEMVT); e.xkn = p.x_kn + l * 256; e.xqn = p.x_qn + l * 256;
            gemm_tile(s, (const bf16_t*)(ws + OFF_WT_CKV), 1024, nt * 256, mt * 256, 0, 2560, e, lds); } }
        else if (it < ndense + nmem + ncomb) { const int idx = (it - ndense - nmem) * 512 + tid_, cch = idx & 7, hs = (idx >> 3) & 3, t = idx >> 5;
            const float* lse = (const float*)(ws + OFF_LSE) + (size_t)t * 12 + hs; const float l0 = lse[0], l1 = lse[4], l2 = lse[8];
            const float M = fmaxf(l0, fmaxf(l1, l2)); float w0 = __expf(l0 - M), w1 = __expf(l1 - M), w2 = __expf(l2 - M); const float iw = 1.f / (w0 + w1 + w2); w0 *= iw; w1 *= iw; w2 *= iw;
            bf16_t* dq = (bf16_t*)(ws + OFF_DQ);
            const u32x4 a = *(const u32x4*)(dq + (size_t)t * 768 + hs * 64 + cch * 8), b = *(const u32x4*)(dq + (size_t)permtok(t, 1) * 768 + (4 + hs) * 64 + cch * 8),
                        c = *(const u32x4*)(dq + (size_t)permtok(t, 2) * 768 + (8 + hs) * 64 + cch * 8);
            u32x4 o;
#pragma unroll
            for (int e = 0; e < 4; ++e) o[e] = pk2(w0 * bflo(a[e]) + w1 * bflo(b[e]) + w2 * bflo(c[e]), w0 * bfhi(a[e]) + w1 * bfhi(b[e]) + w2 * bfhi(c[e]));
            *(u32x4*)(dq + (size_t)t * 768 + hs * 64 + cch * 8) = o; }
        else if (it < ndense + nmem + ncomb + ncv) cvt_item(p, l + 1, mask, it - ndense - nmem - ncomb, lds);
        else cvt_item(p, l, mask2, it - ndense - nmem - ncomb - ncv, lds);
    }
}

__device__ void phaseD(const P& p, int l, char* lds) {
    char* ws = ows(p.ws); const int n = swz_count(128, 4);
#ifdef PROBE_D2
    for (int it = blockIdx.x; it < n; it += gridDim.x) { int mt, nt; if (!swz(it, 128, 4, mt, nt)) continue;
        SrcMix s; s.mq = (const bf16_t*)(ws + OFF_MQ); s.naq = (const bf16_t*)(ws + OFF_NAQ); s.dq = (const bf16_t*)(ws + OFF_DQ); EpiNull e; e.out = p.out;
        gemm_tile(s, (const bf16_t*)(ws + OFF_WT_O), 1024, nt * 256, mt * 256, 0, T, e, lds); }
#endif
    for (int it = blockIdx.x; it < n; it += gridDim.x) { int mt, nt; if (!swz(it, 128, 4, mt, nt)) continue;
        SrcMix s; s.mq = (const bf16_t*)(ws + OFF_MQ); s.naq = (const bf16_t*)(ws + OFF_NAQ); s.dq = (const bf16_t*)(ws + OFF_DQ);
        gemm_tile(s, (const bf16_t*)(ws + OFF_WT_O), 1024, nt * 256, mt * 256, 0, T, epires(p, ws, l, false), lds); }
}
__device__ void phaseE12(const P& p, int l, char* lds) {
    char* ws = ows(p.ws); const unsigned mask = l < 3 ? (1u << W_CKV) : 0u; const int nx = 512, ncv = cvt_count(mask);
    const int tid_ = otid(), wid = tid_ >> 6, lane = tid_ & 63, l31 = lane & 31;
    for (int it = blockIdx.x; it < nx + ncv; it += gridDim.x) {
        if (it < nx) { const int head = it & 3, tb = it >> 2, t0 = tb * 256, t = t0 + wid * 32 + l31;
            const int batch = t0 < NPR ? (t0 >> 11) : 8 + ((t0 - NPR) >> 13);
            EpiQLds e;
            gemm_tile(xbsrc(ws), (const bf16_t*)(ws + OFF_WT_CQ), 1024, head * 256, t0, 0, T, e, lds);
            cross_item((const bf16_t*)(ws + OFF_MEMK) + (size_t)(batch * 256) * 1024 + head * 256,
                       (const bf16_t*)(ws + OFF_MEMVT) + ((size_t)(batch * 1024 + head * 256) << 8), (bf16_t*)(ws + OFF_XO) + (size_t)t * 1024 + head * 256, lds); }
        else cvt_item(p, l + 1, mask, it - nx, lds);
    }
}
__device__ void phaseE3(const P& p, int l, char* lds) {
    char* ws = ows(p.ws); const int n = swz_count(128, 4);
    for (int it = blockIdx.x; it < n; it += gridDim.x) { int mt, nt; if (!swz(it, 128, 4, mt, nt)) continue;
        SrcB s; s.p = (const bf16_t*)(ws + OFF_XO); s.ld = 1024;
        gemm_tile(s, (const bf16_t*)(ws + OFF_WT_CO), 1024, nt * 256, mt * 256, 0, T, epires(p, ws, l, true), lds); }
}
__device__ void phaseF1(const P& p, int l, char* lds) {
    char* ws = ows(p.ws); const int n = swz_count(138, 22);
#ifdef PROBE_F1N
    for (int it = blockIdx.x; it < n; it += gridDim.x) { int mt, nt; if (!swz(it, 138, 22, mt, nt)) continue;
        int sbase, S, m; if (mt < 72) { const int sq = mt / 9; m = mt - sq * 9; sbase = sq * 2048; S = 2048; } else { const int k = mt - 72, sq = k / 33; m = k - sq * 33; sbase = NPR + sq * 8192; S = 8192; }
        EpiNull e; e.out = p.out;
        gemm_tile(xbsrc(ws), (const bf16_t*)(ws + OFF_WT_UP), 1024, nt * 256, sbase + 254 * m - 1, sbase, sbase + S, e, lds); }
#endif
    for (int it = blockIdx.x; it < n; it += gridDim.x) { int mt, nt; if (!swz(it, 138, 22, mt, nt)) continue;
        int sbase, S, m; if (mt < 72) { const int sq = mt / 9; m = mt - sq * 9; sbase = sq * 2048; S = 2048; } else { const int k = mt - 72, sq = k / 33; m = k - sq * 33; sbase = NPR + sq * 8192; S = 8192; }
        EpiFfn e; e.act = (bf16_t*)(ws + OFF_ACT); e.cw = p.conv_w + (size_t)l * 3 * 5632; e.cb = p.conv_b + (size_t)l * 5632; e.sbase = sbase; e.S = S; e.pos0 = 254 * m - 1; e.ft = nt;
        gemm_tile(xbsrc(ws), (const bf16_t*)(ws + OFF_WT_UP), 1024, nt * 256, sbase + 254 * m - 1, sbase, sbase + S, e, lds); }
}
__device__ void phaseF2(const P& p, int l, char* lds) {
    char* ws = ows(p.ws); const unsigned mask = 0u; const int n = swz_count(128, 4), ncv = cvt_count(mask);
    for (int it = blockIdx.x; it < n + ncv; it += gridDim.x) {
        if (it < n) { int mt, nt; if (!swz(it, 128, 4, mt, nt)) continue;
            SrcB s; s.p = (const bf16_t*)(ws + OFF_ACT); s.ld = 2816;
            gemm_tile(s, (const bf16_t*)(ws + OFF_WT_DOWN), 2816, nt * 256, mt * 256, 0, T, epires(p, ws, l, true), lds); }
        else cvt_item(p, l + 1, mask, it - n, lds);
    }
}

__device__ __forceinline__ unsigned gb_ld(unsigned* p) { return __hip_atomic_load(p, __ATOMIC_RELAXED, __HIP_MEMORY_SCOPE_AGENT); }
__device__ __forceinline__ void gsync(unsigned* barw, const unsigned npop, const unsigned nx, unsigned& k) {
    asm volatile("s_waitcnt vmcnt(0) lgkmcnt(0)" ::: "memory");
    __syncthreads();
    k += 1u;
    if (threadIdx.x == 0) {
        const unsigned a = __hip_atomic_fetch_add(barw + 512 + 64 * xcc_id(), 1u, __ATOMIC_RELAXED, __HIP_MEMORY_SCOPE_AGENT) + 1u;
        if (a == k * npop) {
            __builtin_amdgcn_fence(__ATOMIC_RELEASE, "agent"); asm volatile("s_waitcnt vmcnt(0)" ::: "memory");
            const unsigned t = __hip_atomic_fetch_add(barw + 1024, 1u, __ATOMIC_RELAXED, __HIP_MEMORY_SCOPE_AGENT) + 1u;
            if (t == k * nx) {
#pragma unroll
                for (int j = 0; j < 8; ++j) __hip_atomic_store(barw + 1088 + 64 * j, k, __ATOMIC_RELAXED, __HIP_MEMORY_SCOPE_AGENT); }
        }
        { unsigned* gw = barw + 1088 + 64 * xcc_id(); while (gb_ld(gw) < k) __builtin_amdgcn_s_sleep(1); }
        __builtin_amdgcn_fence(__ATOMIC_ACQUIRE, "agent"); asm volatile("s_waitcnt vmcnt(0)" ::: "memory");
    }
    __syncthreads();
}
#ifndef PROBE_T
#define PROBE_T 0
#endif
#ifndef PROBE_R
#define PROBE_R 0
#endif
#define PROBING ((PROBE_T) != 0 || (PROBE_R) != 0)
#define TICK(ph) do { if (PROBING && blockIdx.x == 0 && threadIdx.x == 0) { volatile unsigned long long* pb_ = (volatile unsigned long long*)(lds + LDS_BYTES - 64); const unsigned long long now_ = wall_clock64(), dt_ = now_ - pb_[0]; pb_[0] = now_; pb_[1] += dt_; \
        if ((PROBE_T) & (1u << (ph))) pb_[2] += dt_; if ((PROBE_R) & (1u << (ph))) pb_[3] += dt_; } } while (0)
__global__ void __launch_bounds__(512, 2) mega(const P p) {
    __shared__ __attribute__((aligned(16))) char lds[LDS_BYTES];
    cg::grid_group grid = cg::this_grid();
    if (threadIdx.x == 0) __hip_atomic_fetch_add((unsigned*)(p.ws + OFF_BAR) + 64 * xcc_id(), 1u, __ATOMIC_RELAXED, __HIP_MEMORY_SCOPE_AGENT);
    if (PROBING && blockIdx.x == 0 && threadIdx.x == 0) { volatile unsigned long long* pb_ = (volatile unsigned long long*)(lds + LDS_BYTES - 64); pb_[0] = wall_clock64(); pb_[1] = 0; pb_[2] = 0; pb_[3] = 0; }
    phase0(p, lds); grid.sync(); TICK(0);
    unsigned* barw = (unsigned*)(p.ws + OFF_BAR); unsigned nx = 0u, bk = 0u;
#pragma unroll
    for (int i = 0; i < 8; ++i) nx += gb_ld(barw + 64 * i) != 0u ? 1u : 0u;
    nx = __builtin_amdgcn_readfirstlane(nx); const unsigned npop = __builtin_amdgcn_readfirstlane(gb_ld(barw + 64 * xcc_id()));
    for (int l = 0; l < 4; ++l) {
        phaseA(p, l, lds); gsync(barw, npop, nx, bk); TICK(1);
        phaseB(p, l, lds); gsync(barw, npop, nx, bk); TICK(2);
        phaseC(p, l, lds); gsync(barw, npop, nx, bk); TICK(3);
        phaseD(p, l, lds); gsync(barw, npop, nx, bk); TICK(4);
        phaseE12(p, l, lds); gsync(barw, npop, nx, bk); TICK(6);
        phaseE3(p, l, lds); gsync(barw, npop, nx, bk); TICK(7);
        phaseF1(p, l, lds); gsync(barw, npop, nx, bk); TICK(8);
        phaseF2(p, l, lds); if (l < 3 || PROBING) gsync(barw, npop, nx, bk); TICK(9);
    }
    if (PROBING && blockIdx.x == 0) {
        float* fr = (float*)lds;
        if (threadIdx.x == 0) { volatile unsigned long long* pb_ = (volatile unsigned long long*)(lds + LDS_BYTES - 64); const unsigned long long tselT = pb_[2], tselR = pb_[3], ttot = pb_[1];
            const unsigned long long t0 = wall_clock64(); while (wall_clock64() - t0 < tselT) __builtin_amdgcn_s_sleep(32);
            fr[0] = (float)((double)tselR / (double)ttot); }
        __syncthreads();
        const float d = sqrtf(fr[0]) * 0.3f;
        if ((PROBE_R) != 0) for (int i = threadIdx.x; i < 4096; i += 512) p.out[i] += d;
    }
}

extern "C" void kernel_launch(void* const* d_in, const int* in_sizes, int n_in, void* d_out, int out_size, void* d_ws, size_t ws_size, hipStream_t stream) {
    static int grid_blocks = 0;
    if (!grid_blocks) { int dev = 0, cus = 0, per_cu = 0; (void)hipGetDevice(&dev); (void)hipDeviceGetAttribute(&cus, hipDeviceAttributeMultiprocessorCount, dev);
        (void)hipOccupancyMaxActiveBlocksPerMultiprocessor(&per_cu, mega, 512, 0); if (per_cu > 1) per_cu = 1; grid_blocks = cus * per_cu; }
    if (ws_size < WS_NEED) { fprintf(stderr, "workspace too small: %zu < %zu\n", ws_size, (size_t)WS_NEED); return; }
    P p; memset(&p, 0, sizeof(p));
    const float** f = (const float**)&p.xp;
    for (int i = 0; i < 31; ++i) f[i] = (const float*)d_in[i];
    p.out = (float*)d_out; p.ws = (char*)d_ws;
    for (int i = 0; i < 32; ++i) p.inv32[i] = (float)pow(10000.0, -(double)i / 32.0);
    for (int i = 0; i < 16; ++i) p.inv16[i] = (float)pow(10000.0, -(double)i / 16.0);
    (void)hipMemsetAsync((char*)d_ws + OFF_BAR, 0, 8192, stream);
    void* args[] = {(void*)&p};
    hipError_t e = hipLaunchCooperativeKernel((void*)mega, dim3(grid_blocks), dim3(512), args, 0, stream);
    if (e != hipSuccess) fprintf(stderr, "cooperative launch failed: %s (grid %d)\n", hipGetErrorString(e), grid_blocks);
}
```

```cpp
#include <hip/hip_runtime.h>
#include <hip/hip_cooperative_groups.h>
#include <cstdio>
#include <cmath>
#include <cstring>
namespace cg = cooperative_groups;

typedef unsigned short bf16_t;
typedef short bf16x8 __attribute__((ext_vector_type(8)));
typedef short s16x4 __attribute__((ext_vector_type(4)));
typedef float f32x16 __attribute__((ext_vector_type(16)));
typedef float f32x4 __attribute__((ext_vector_type(4)));
typedef float f32x2 __attribute__((ext_vector_type(2)));
typedef unsigned u32x4 __attribute__((ext_vector_type(4)));
typedef unsigned u32x2 __attribute__((ext_vector_type(2)));

#define MFMA32(a, b, c) __builtin_amdgcn_mfma_f32_32x32x16_bf16((a), (b), (c), 0, 0, 0)

constexpr int T = 32768;
constexpr int TP = T + 128;
constexpr int NPR = 16384;
constexpr float EPS = 1e-6f;
constexpr float LOG2E = 1.4426950408889634f;
constexpr int LDS_SSX = 139264;
constexpr int LDS_BYTES = 141568;

constexpr size_t SZ_WT_IN = (size_t)4096 * 1024 * 2, SZ_WT_UQ = (size_t)768 * 256 * 2, SZ_WT_UKV = (size_t)768 * 128 * 2,
                 SZ_WT_SQ = (size_t)1024 * 1024 * 2, SZ_WT_UP = (size_t)5632 * 1024 * 2, SZ_WT_DOWN = (size_t)1024 * 2816 * 2,
                 SZ_WT_CKV = (size_t)2048 * 1024 * 2;
constexpr size_t OFF_WT_IN = 0, OFF_WT_UQ = OFF_WT_IN + SZ_WT_IN, OFF_WT_UKV = OFF_WT_UQ + SZ_WT_UQ, OFF_WT_O = OFF_WT_UKV + SZ_WT_UKV,
                 OFF_WT_CQ = OFF_WT_O + SZ_WT_SQ, OFF_WT_CO = OFF_WT_CQ + SZ_WT_SQ, OFF_WT_UP = OFF_WT_CO + SZ_WT_SQ,
                 OFF_WT_DOWN = OFF_WT_UP + SZ_WT_UP, OFF_WT_CKV = OFF_WT_DOWN + SZ_WT_DOWN;
constexpr size_t OFF_MEMK = OFF_WT_CKV + SZ_WT_CKV;
constexpr size_t OFF_MEMVT = OFF_MEMK + (size_t)2560 * 1024 * 2;
constexpr size_t OFF_MEMSS = OFF_MEMVT + (size_t)2560 * 1024 * 2;
constexpr size_t OFF_ROPE32 = OFF_MEMSS + (size_t)2560 * 16 * 4;
constexpr size_t OFF_ROPE16 = OFF_ROPE32 + (size_t)8192 * 32 * 8;
constexpr size_t OFF_LSE = OFF_ROPE16 + (size_t)8192 * 16 * 8;
constexpr size_t OFF_SSP = OFF_LSE + (size_t)T * 12 * 4;
constexpr size_t OFF_ZSS = OFF_SSP + (size_t)T * 16 * 4;
constexpr size_t OFF_MEMB = OFF_ZSS + (size_t)T * 8 * 4;
constexpr size_t OFF_MEMSSP = OFF_MEMB + (size_t)2560 * 1024 * 2;
constexpr size_t OFF_CTR = OFF_MEMSSP + (size_t)2560 * 16 * 4;
constexpr size_t OFF_BAR = OFF_CTR + 256;
constexpr size_t OFF_MQ = OFF_BAR + 8192;
constexpr size_t OFF_MK = OFF_MQ + (size_t)T * 576 * 2;
constexpr size_t OFF_MVT = OFF_MK + (size_t)T * 576 * 2;
constexpr size_t OFF_XB = OFF_MK;
constexpr size_t OFF_Z = OFF_MK + (size_t)T * 1024 * 2;
constexpr size_t OFF_ZC = OFF_Z;
constexpr size_t OFF_NAQ = OFF_ZC + (size_t)T * 416 * 2;
constexpr size_t OFF_NAK = OFF_NAQ + (size_t)T * 384 * 2;
constexpr size_t OFF_NAVT = OFF_NAK + (size_t)T * 384 * 2;
constexpr size_t OFF_DQ = OFF_NAVT + (size_t)TP * 384 * 2;
constexpr size_t OFF_DK = OFF_DQ + (size_t)T * 768 * 2;
constexpr size_t OFF_DVT = OFF_DK + (size_t)T * 768 * 2;
constexpr size_t WS_NEED = OFF_DVT + (size_t)TP * 768 * 2;
constexpr size_t OFF_XQ = OFF_Z;
constexpr size_t OFF_XO = OFF_XQ + (size_t)T * 1024 * 2;
constexpr size_t OFF_ACT = OFF_Z;

struct P {
    const float *xp, *xs, *memp, *mems;
    const float *norm_mix, *w_in, *mla_q_norm, *mla_kv_norm, *w_uq, *w_uk, *w_uv, *mla_qn, *mla_kn, *na_qn, *na_kn, *na_rpb, *dil_qn,
        *dil_kn, *w_o, *norm_cross, *norm_mem, *w_cq, *w_ckv, *x_qn, *x_kn, *w_co, *norm_ffn, *w_up, *conv_w, *conv_b, *w_down;
    float* out;
    char* ws;
    float inv32[32];
    float inv16[16];
};

__device__ __forceinline__ unsigned pk2(float lo, float hi) { unsigned r; asm("v_cvt_pk_bf16_f32 %0, %1, %2" : "=v"(r) : "v"(lo), "v"(hi)); return r; }
__device__ __forceinline__ float bflo(unsigned u) { return __uint_as_float(u << 16); }
__device__ __forceinline__ float bfhi(unsigned u) { return __uint_as_float(u & 0xffff0000u); }
__device__ __forceinline__ bf16_t f2bf(float f) { return (bf16_t)(pk2(f, f) & 0xffffu); }
__device__ __forceinline__ int otid() { int t = threadIdx.x; asm volatile("" : "+v"(t)); return t; }
__device__ __forceinline__ int xcc_id() { return (int)(__builtin_amdgcn_s_getreg((3 << 11) | 20) & 7u); }
__device__ __forceinline__ char* ows(char* w) { asm volatile("" : "+s"(w)); return w; }
__device__ __forceinline__ float vmax3(float a, float b, float c) { return __builtin_amdgcn_fmed3f(__builtin_amdgcn_fmed3f(a, b, __builtin_inff()), c, __builtin_inff()); }
__device__ __forceinline__ int crow(int r, int hh) { return (r & 3) + 8 * (r >> 2) + 4 * hh; }
__device__ __forceinline__ void tokinfo(int t, int& sbase, int& S) {
    if (t < NPR) { S = 2048; sbase = t & ~2047; } else { S = 8192; sbase = NPR + ((t - NPR) & ~8191); }
}
__device__ __forceinline__ int permtok(int t, int g) {
    int sbase, S; tokinfo(t, sbase, S); const int sh = 2 * g, pos = t - sbase;
    return sbase + (pos & ((1 << sh) - 1)) * (S >> sh) + (pos >> sh);
}

__device__ __forceinline__ bool swz(int it, int MT, int NT, int& mt, int& nt) {
#ifdef XCD_CHUNKED
    const int x = (it >> 5) & 7, j = ((it >> 8) << 5) | (it & 31);
#else
    const int x = it & 7, j = it >> 3;
#endif
    const int m_lo = (MT * x) >> 3, m_hi = (MT * (x + 1)) >> 3, mc = m_hi - m_lo;
    if (j >= mc * NT) return false;
    const int grp = j / (8 * NT), rem = j - grp * 8 * NT;
    int gsz = mc - grp * 8; gsz = gsz > 8 ? 8 : gsz;
    nt = rem / gsz; mt = m_lo + grp * 8 + (rem - nt * gsz); return true;
}
#ifdef XCD_CHUNKED
__host__ __device__ constexpr int swz_count(int MT, int NT) { return ((((MT + 7) / 8) * NT + 31) / 32) * 256; }
#else
__host__ __device__ constexpr int swz_count(int MT, int NT) { return 8 * ((MT + 7) / 8) * NT; }
#endif

struct CvtJob { const float* src; bf16_t* dst; const float* gain; int K, N, mode; };
__device__ __forceinline__ int rowmap(int mode, int n) {
    if (mode == 1) return n < 416 ? n : n + 96;
    if (mode == 2) return (n / 96) * 128 + (n % 96);
    if (mode == 3) { const int g = n >= 2816, f = g ? n - 2816 : n; return (f >> 7) * 256 + g * 128 + (f & 127); }
    return n;
}
__device__ __forceinline__ void cvt_tile(const CvtJob& j, int pair, int ntiles, char* lds) {
    const int tid8 = otid(), half = tid8 >> 8, tid = tid8 & 255, tile = pair * 2 + half; const bool on = tile < ntiles;
    const int ntn = (j.N + 63) >> 6, tk = tile / ntn, tn = tile - tk * ntn, k0 = tk * 64, n0 = tn * 64;
    float* tl = (float*)lds + half * (64 * 65);
    if (on) { const int tx = tid & 63, ty = tid >> 6, n = n0 + tx;
#pragma unroll
      for (int i = 0; i < 16; ++i) { const int k = k0 + ty * 16 + i; float v = (n < j.N) ? j.src[(size_t)k * j.N + n] : 0.f; if (j.gain) v *= j.gain[k]; tl[tx * 65 + ty * 16 + i] = v; } }
    __syncthreads();
    if (on) { const int rn = tid >> 2, c = tid & 3, n = n0 + rn;
      if (n < j.N) { const float* s = tl + rn * 65 + c * 16; bf16_t* d = j.dst + (size_t)rowmap(j.mode, n) * j.K + k0 + c * 16;
        u32x4 a = {pk2(s[0], s[1]), pk2(s[2], s[3]), pk2(s[4], s[5]), pk2(s[6], s[7])}, b = {pk2(s[8], s[9]), pk2(s[10], s[11]), pk2(s[12], s[13]), pk2(s[14], s[15])};
        *(u32x4*)d = a; *(u32x4*)(d + 8) = b; } }
    __syncthreads();
}
enum { W_IN = 0, W_UQ, W_UK, W_UV, W_O, W_CQ, W_CO, W_UP, W_DOWN, W_CKV, W_NUM };
__host__ __device__ constexpr int cvt_tiles(int w) {
    return w == W_IN ? 16 * 61 : w == W_UQ ? 4 * 9 : (w == W_UK || w == W_UV) ? 2 * 6 : (w == W_O || w == W_CQ || w == W_CO) ? 256 : w == W_UP ? 16 * 88 : w == W_DOWN ? 44 * 16 : 16 * 32;
}
__host__ __device__ constexpr int cvt_count(unsigned mask) { int n = 0; for (int w = 0; w < W_NUM; ++w) if (mask & (1u << w)) n += (cvt_tiles(w) + 1) / 2; return n; }
__device__ __forceinline__ CvtJob get_cvt(const P& p, int l, int w) {
    CvtJob j; j.gain = nullptr; j.mode = 0;
    switch (w) {
    case W_IN: j.src = p.w_in + (size_t)l * 1024 * 3872; j.dst = (bf16_t*)(p.ws + OFF_WT_IN); j.gain = p.norm_mix + l * 1024; j.K = 1024; j.N = 3872; j.mode = 1; break;
    case W_UQ: j.src = p.w_uq + (size_t)l * 256 * 576; j.dst = (bf16_t*)(p.ws + OFF_WT_UQ); j.gain = p.mla_q_norm + l * 256; j.K = 256; j.N = 576; j.mode = 2; break;
    case W_UK: j.src = p.w_uk + (size_t)l * 128 * 384; j.dst = (bf16_t*)(p.ws + OFF_WT_UKV); j.gain = p.mla_kv_norm + l * 128; j.K = 128; j.N = 384; break;
    case W_UV: j.src = p.w_uv + (size_t)l * 128 * 384; j.dst = (bf16_t*)(p.ws + OFF_WT_UKV) + 384 * 128; j.gain = p.mla_kv_norm + l * 128; j.K = 128; j.N = 384; break;
    case W_O: j.src = p.w_o + (size_t)l * 1024 * 1024; j.dst = (bf16_t*)(p.ws + OFF_WT_O); j.K = 1024; j.N = 1024; break;
    case W_CQ: j.src = p.w_cq + (size_t)l * 1024 * 1024; j.dst = (bf16_t*)(p.ws + OFF_WT_CQ); j.gain = p.norm_cross + l * 1024; j.K = 1024; j.N = 1024; break;
    case W_CO: j.src = p.w_co + (size_t)l * 1024 * 1024; j.dst = (bf16_t*)(p.ws + OFF_WT_CO); j.K = 1024; j.N = 1024; break;
    case W_UP: j.src = p.w_up + (size_t)l * 1024 * 5632; j.dst = (bf16_t*)(p.ws + OFF_WT_UP); j.gain = p.norm_ffn + l * 1024; j.K = 1024; j.N = 5632; j.mode = 3; break;
    case W_DOWN: j.src = p.w_down + (size_t)l * 2816 * 1024; j.dst = (bf16_t*)(p.ws + OFF_WT_DOWN); j.K = 2816; j.N = 1024; break;
    default: j.src = p.w_ckv + (size_t)l * 1024 * 2048; j.dst = (bf16_t*)(p.ws + OFF_WT_CKV); j.gain = p.norm_mem + l * 1024; j.K = 1024; j.N = 2048; break;
    }
    return j;
}
__device__ __forceinline__ void cvt_item(const P& p, int l, unsigned mask, int it, char* lds) {
    for (int w = 0; w < W_NUM; ++w) if (mask & (1u << w)) { const int n = (cvt_tiles(w) + 1) / 2; if (it < n) { CvtJob j = get_cvt(p, l, w); cvt_tile(j, it, cvt_tiles(w), lds); return; } it -= n; }
}

struct SrcX {
    const float *p0, *p1; int split;
    __device__ __forceinline__ const float* row(int t) const { return (t < split ? p0 : p1) + (size_t)t * 1024; }
};
struct SrcXb {
    const bf16_t* xb; const float* ssp;
    __device__ __forceinline__ const bf16_t* ptrb(int t, int k0) const { return xb + (size_t)t * 1024 + k0; }
    __device__ __forceinline__ float rstd(int t) const { const f32x4* q = (const f32x4*)(ssp + (size_t)t * 16); const f32x4 a = q[0], b = q[1], c = q[2], d = q[3];
        return rsqrtf(((a[0] + a[1] + a[2] + a[3]) + (b[0] + b[1] + b[2] + b[3]) + (c[0] + c[1] + c[2] + c[3]) + (d[0] + d[1] + d[2] + d[3])) * (1.f / 1024.f) + EPS); }
};
template <int NSS> struct SrcZ {
    const bf16_t* p; const float* zss;
    __device__ __forceinline__ const bf16_t* ptrb(int t, int k0) const { return p + (size_t)t * 416 + k0; }
    __device__ __forceinline__ float rstd(int t) const { float a = 0.f;
#pragma unroll
        for (int i = 0; i < NSS; ++i) a += zss[(size_t)t * 8 + i];
        return rsqrtf(a * (1.f / (64.f * NSS)) + EPS); }
};
struct SrcB {
    const bf16_t* p; int ld;
    __device__ __forceinline__ const bf16_t* ptrb(int t, int k0) const { return p + (size_t)t * ld + k0; }
    __device__ __forceinline__ float rstd(int) const { return 1.f; }
};
struct SrcMix {
    const bf16_t *mq, *naq, *dq;
    __device__ __forceinline__ const bf16_t* ptrb(int t, int k0) const {
        if (k0 < 384) return mq + (size_t)t * 576 + (k0 >> 6) * 96 + (k0 & 63);
        if (k0 < 768) return naq + (size_t)t * 384 + (k0 - 384);
        return dq + (size_t)t * 768 + (k0 - 768);
    }
    __device__ __forceinline__ float rstd(int) const { return 1.f; }
};
struct TileCtx { int f0, tok0, wm, wn, l31, hh, wid, lane; float rs[2]; };

#define WAIT_V(n) asm volatile("s_waitcnt vmcnt(%0)" ::"n"(n) : "memory")
#define RAW_BARRIER() do { asm volatile("s_waitcnt lgkmcnt(0)" ::: "memory"); __builtin_amdgcn_s_barrier(); } while (0)
#define GLDS(g, l) __builtin_amdgcn_global_load_lds((const unsigned*)(g), (unsigned*)(l), 16, 0, 0)

constexpr int STG = 65536;
template <class Src, class Epi>
__device__ __forceinline__ void gemm_tile(const Src src, const bf16_t* __restrict__ Wt, const int K, const int f0, const int tok0, const int vlo, const int vhi,
                                          const Epi epi, char* lds) {
    const int tid = otid(), lane = tid & 63, wid = tid >> 6, wm = wid >> 2, wn = wid & 3, l31 = lane & 31, hh = lane >> 5;
    const int q = lane >> 3, ch8 = ((lane & 7) ^ ((4 * (wid & 1) + (q >> 1)) & 7)) * 8;
    int ra[4];
#pragma unroll
    for (int i = 0; i < 4; ++i) { int r = tok0 + 8 * wid + 64 * i + q; ra[i] = r < vlo ? vlo : (r >= vhi ? vhi - 1 : r); }
    const bf16_t* wp0 = Wt + (size_t)(f0 + 8 * wid + q) * K + ch8; const size_t w64 = (size_t)64 * K;
    const int y = (l31 >> 1) & 7;
    const int oW = (wm * 128 + l31) * 128, oA = 32768 + (wn * 64 + l31) * 128;
    int cx[4];
#pragma unroll
    for (int ks = 0; ks < 4; ++ks) cx[ks] = ((2 * ks + hh) ^ y) << 4;
    f32x16 acc[4][2];
#pragma unroll
    for (int i = 0; i < 4; ++i)
#pragma unroll
        for (int j = 0; j < 2; ++j)
#pragma unroll
            for (int r = 0; r < 16; ++r) acc[i][j][r] = 0.f;
    const int nk = K >> 6;
#define STAGE(st_, k0_) do { char* d_ = lds + (st_) * STG + wid * 1024;                                                                                                  \
        _Pragma("unroll") for (int i_ = 0; i_ < 4; ++i_) GLDS(wp0 + i_ * w64 + (k0_), d_ + i_ * 8192);                                                                   \
        _Pragma("unroll") for (int i_ = 0; i_ < 4; ++i_) GLDS(src.ptrb(ra[i_], (k0_)) + ch8, d_ + 32768 + i_ * 8192); } while (0)
#define KPAIR(k0_, k1_) do {                                                               \
        const bf16x8 b00 = *(const bf16x8*)(sb + oA + cx[k0_]), b01 = *(const bf16x8*)(sb + oA + 4096 + cx[k0_]), a00 = *(const bf16x8*)(sb + oW + cx[k0_]),             \
                     a01 = *(const bf16x8*)(sb + oW + 4096 + cx[k0_]), a02 = *(const bf16x8*)(sb + oW + 8192 + cx[k0_]), a03 = *(const bf16x8*)(sb + oW + 12288 + cx[k0_]); \
        const bf16x8 b10 = *(const bf16x8*)(sb + oA + cx[k1_]), b11 = *(const bf16x8*)(sb + oA + 4096 + cx[k1_]), a10 = *(const bf16x8*)(sb + oW + cx[k1_]),             \
                     a11 = *(const bf16x8*)(sb + oW + 4096 + cx[k1_]), a12 = *(const bf16x8*)(sb + oW + 8192 + cx[k1_]), a13 = *(const bf16x8*)(sb + oW + 12288 + cx[k1_]); \
        __builtin_amdgcn_sched_barrier(0);                                                                                                                               \
        acc[0][0] = MFMA32(a00, b00, acc[0][0]); acc[0][1] = MFMA32(a00, b01, acc[0][1]); acc[1][0] = MFMA32(a01, b00, acc[1][0]); acc[1][1] = MFMA32(a01, b01, acc[1][1]); \
        acc[2][0] = MFMA32(a02, b00, acc[2][0]); acc[2][1] = MFMA32(a02, b01, acc[2][1]); acc[3][0] = MFMA32(a03, b00, acc[3][0]); acc[3][1] = MFMA32(a03, b01, acc[3][1]); \
        acc[0][0] = MFMA32(a10, b10, acc[0][0]); acc[0][1] = MFMA32(a10, b11, acc[0][1]); acc[1][0] = MFMA32(a11, b10, acc[1][0]); acc[1][1] = MFMA32(a11, b11, acc[1][1]); \
        acc[2][0] = MFMA32(a12, b10, acc[2][0]); acc[2][1] = MFMA32(a12, b11, acc[2][1]); acc[3][0] = MFMA32(a13, b10, acc[3][0]); acc[3][1] = MFMA32(a13, b11, acc[3][1]); \
        __builtin_amdgcn_sched_barrier(0); } while (0)
    STAGE(0, 0);
    for (int kt = 0; kt < nk; ++kt) {
        WAIT_V(0);
        RAW_BARRIER();
        if (kt + 1 < nk) STAGE((kt + 1) & 1, (kt + 1) * 64);
        const char* sb = lds + (kt & 1) * STG;
        KPAIR(0, 1); KPAIR(2, 3);
    }
#undef STAGE
#undef KPAIR
    RAW_BARRIER();
    TileCtx c; c.tok0 = tok0; c.wm = wm; c.wn = wn; c.l31 = l31; c.hh = hh; c.wid = wid; c.lane = lane;
    { int t0 = tok0 + wn * 64 + l31, t1 = t0 + 32; t0 = t0 < vlo ? vlo : (t0 >= vhi ? vhi - 1 : t0); t1 = t1 < vlo ? vlo : (t1 >= vhi ? vhi - 1 : t1);
      c.rs[0] = src.rstd(t0); c.rs[1] = src.rstd(t1); }
    if constexpr (Epi::FULL) { c.f0 = f0; epi(acc, c, lds); }
    else {
        c.f0 = f0 + wm * 64; epi(*(f32x16(*)[2][2])&acc[0], c, lds);
        c.f0 = f0 + wm * 64 + 64; epi(*(f32x16(*)[2][2])&acc[2], c, lds);
    }
    __syncthreads();
}

__device__ __forceinline__ void st4(bf16_t* p, float a, float b, float c, float d) { u32x2 w = {pk2(a, b), pk2(c, d)}; *(u32x2*)p = w; }
constexpr int EPI_WREG = 17408;

template <class RowPtr>
__device__ __forceinline__ void put_rows_bf16(char* lds, const TileCtx& c, const f32x16 (&v)[2][2], const int nch, RowPtr rowptr) {
    bf16_t* R = (bf16_t*)(lds + c.wid * EPI_WREG);
#pragma unroll
    for (int nt = 0; nt < 2; ++nt)
#pragma unroll
        for (int mt = 0; mt < 2; ++mt)
#pragma unroll
            for (int g = 0; g < 4; ++g) st4(R + (nt * 32 + c.l31) * 72 + mt * 32 + 8 * g + 4 * c.hh, v[mt][nt][4 * g], v[mt][nt][4 * g + 1], v[mt][nt][4 * g + 2], v[mt][nt][4 * g + 3]);
    const int rr = c.lane >> 3, ch = c.lane & 7;
#pragma unroll
    for (int i = 0; i < 8; ++i) { const int tl = 8 * i + rr; const u32x4 w = *(const u32x4*)(R + tl * 72 + ch * 8); if (ch < nch) *(u32x4*)(rowptr(tl) + ch * 8) = w; }
}

struct EpiIn {
    static constexpr bool FULL = false;
    bf16_t *zc, *naq, *nak, *navT, *dq, *dk, *dvT; float* zss; const float *na_qn, *na_kn, *dil_qn, *dil_kn; const f32x2* rope32;
    __device__ __forceinline__ void operator()(f32x16 (&acc)[2][2], const TileCtx& c, char*) const {
        const int fw = c.f0 + c.wm * 64;
        if (fw >= 3968) return;
        if (fw < 512) {
#pragma unroll
            for (int nt = 0; nt < 2; ++nt) { const int t = c.tok0 + c.wn * 64 + nt * 32 + c.l31; const float rs = c.rs[nt]; float ss = 0.f;
#pragma unroll
                for (int mt = 0; mt < 2; ++mt) { const int fb = fw + mt * 32; if (fb >= 416) continue;
#pragma unroll
                    for (int r = 0; r < 16; ++r) { const float v = acc[mt][nt][r] * rs; acc[mt][nt][r] = v; ss += v * v; }
#pragma unroll
                    for (int g = 0; g < 4; ++g) st4(zc + (size_t)t * 416 + fb + 8 * g + 4 * c.hh, acc[mt][nt][4 * g], acc[mt][nt][4 * g + 1], acc[mt][nt][4 * g + 2], acc[mt][nt][4 * g + 3]); }
                ss += __shfl_xor(ss, 32); if (c.hh == 0 && fw < 384) zss[(size_t)t * 8 + (fw >> 6)] = ss; }
        } else if (fw < 1664) {
            const int pf = fw - 512, which = pf / 384, head = (pf - which * 384) >> 6;
            if (which < 2) { const float* gain = which ? na_kn : na_qn; bf16_t* dst = which ? nak : naq;
#pragma unroll
                for (int nt = 0; nt < 2; ++nt) { const int t = c.tok0 + c.wn * 64 + nt * 32 + c.l31; const float rs = c.rs[nt]; float ss = 0.f;
#pragma unroll
                    for (int mt = 0; mt < 2; ++mt)
#pragma unroll
                        for (int r = 0; r < 16; ++r) { const float v = acc[mt][nt][r] * rs; acc[mt][nt][r] = v; ss += v * v; }
                    ss += __shfl_xor(ss, 32); const float rq = rsqrtf(ss * (1.f / 64.f) + EPS);
#pragma unroll
                    for (int mt = 0; mt < 2; ++mt)
#pragma unroll
                        for (int g = 0; g < 4; ++g) { const int d = mt * 32 + 8 * g + 4 * c.hh; const f32x4 gn = *(const f32x4*)(gain + d);
                            st4(dst + (size_t)t * 384 + head * 64 + d, acc[mt][nt][4 * g] * rq * gn[0], acc[mt][nt][4 * g + 1] * rq * gn[1], acc[mt][nt][4 * g + 2] * rq * gn[2], acc[mt][nt][4 * g + 3] * rq * gn[3]); } }
            } else {
#pragma unroll
                for (int nt = 0; nt < 2; ++nt) { const int t = c.tok0 + c.wn * 64 + nt * 32 + c.l31; const float rs = c.rs[nt];
#pragma unroll
                    for (int mt = 0; mt < 2; ++mt)
#pragma unroll
                        for (int r = 0; r < 16; ++r) navT[(size_t)(head * 64 + mt * 32 + crow(r, c.hh)) * TP + t] = f2bf(acc[mt][nt][r] * rs); }
            }
        } else {
            const int pf = fw - 1664, which = pf / 768, h12 = (pf - which * 768) >> 6, g4 = h12 >> 2;
#pragma unroll
            for (int nt = 0; nt < 2; ++nt) { const int t = c.tok0 + c.wn * 64 + nt * 32 + c.l31; const float rs = c.rs[nt];
                int sbase, S; tokinfo(t, sbase, S); const int pos = t - sbase, sh = 2 * g4; const int tp = sbase + (pos & ((1 << sh) - 1)) * (S >> sh) + (pos >> sh);
                if (which < 2) { const float* gain = which ? dil_kn : dil_qn; bf16_t* dst = which ? dk : dq; float ss = 0.f;
#pragma unroll
                    for (int mt = 0; mt < 2; ++mt)
#pragma unroll
                        for (int r = 0; r < 16; ++r) { const float v = acc[mt][nt][r] * rs; acc[mt][nt][r] = v; ss += v * v; }
                    ss += __shfl_xor(ss, 32); const float rq = rsqrtf(ss * (1.f / 64.f) + EPS);
#pragma unroll
                    for (int g = 0; g < 4; ++g) { const int d = 8 * g + 4 * c.hh; const f32x4 g1 = *(const f32x4*)(gain + d), g2 = *(const f32x4*)(gain + 32 + d);
                        const f32x4 cs0 = *(const f32x4*)(rope32 + pos * 32 + d), cs1 = *(const f32x4*)(rope32 + pos * 32 + d + 2);
                        float o1[4], o2[4];
#pragma unroll
                        for (int j = 0; j < 4; ++j) { const float x1 = acc[0][nt][4 * g + j] * rq * g1[j], x2 = acc[1][nt][4 * g + j] * rq * g2[j];
                            const float cc = j < 2 ? cs0[2 * j] : cs1[2 * (j - 2)], sn = j < 2 ? cs0[2 * j + 1] : cs1[2 * (j - 2) + 1];
                            o1[j] = x1 * cc - x2 * sn; o2[j] = x2 * cc + x1 * sn; }
                        st4(dst + (size_t)tp * 768 + h12 * 64 + d, o1[0], o1[1], o1[2], o1[3]); st4(dst + (size_t)tp * 768 + h12 * 64 + 32 + d, o2[0], o2[1], o2[2], o2[3]); }
                } else {
#pragma unroll
                    for (int mt = 0; mt < 2; ++mt)
#pragma unroll
                        for (int r = 0; r < 16; ++r) dvT[(size_t)(h12 * 64 + mt * 32 + crow(r, c.hh)) * TP + tp] = f2bf(acc[mt][nt][r] * rs);
                } }
        }
    }
};

struct EpiUq {
    static constexpr bool FULL = true;
    bf16_t* mq; const float* qn; const f32x2* rope16;
    __device__ __forceinline__ void operator()(f32x16 (&acc)[4][2], const TileCtx& c, char*) const {
        const int head = (c.f0 >> 7) + c.wm;
#pragma unroll
        for (int nt = 0; nt < 2; ++nt) { const int t = c.tok0 + c.wn * 64 + nt * 32 + c.l31; float ss = 0.f;
#pragma unroll
            for (int mt = 0; mt < 3; ++mt)
#pragma unroll
                for (int r = 0; r < 16; ++r) { const float v = acc[mt][nt][r] * c.rs[nt]; acc[mt][nt][r] = v; ss += v * v; }
            ss += __shfl_xor(ss, 32); const float rq = rsqrtf(ss * (1.f / 96.f) + EPS);
            int sbase, S; tokinfo(t, sbase, S); const int pos = t - sbase; bf16_t* dst = mq + (size_t)t * 576 + head * 96;
#pragma unroll
            for (int mt = 0; mt < 2; ++mt)
#pragma unroll
                for (int g = 0; g < 4; ++g) { const int d = mt * 32 + 8 * g + 4 * c.hh; const f32x4 gn = *(const f32x4*)(qn + d);
                    st4(dst + d, acc[mt][nt][4 * g] * rq * gn[0], acc[mt][nt][4 * g + 1] * rq * gn[1], acc[mt][nt][4 * g + 2] * rq * gn[2], acc[mt][nt][4 * g + 3] * rq * gn[3]); }
#pragma unroll
            for (int g = 0; g < 2; ++g) { const int i = 8 * g + 4 * c.hh; const f32x4 g1 = *(const f32x4*)(qn + 64 + i), g2 = *(const f32x4*)(qn + 80 + i);
                const f32x4 cs0 = *(const f32x4*)(rope16 + pos * 16 + i), cs1 = *(const f32x4*)(rope16 + pos * 16 + i + 2); float o1[4], o2[4];
#pragma unroll
                for (int j = 0; j < 4; ++j) { const float x1 = acc[2][nt][4 * g + j] * rq * g1[j], x2 = acc[2][nt][8 + 4 * g + j] * rq * g2[j];
                    const float cc = j < 2 ? cs0[2 * j] : cs1[2 * (j - 2)], sn = j < 2 ? cs0[2 * j + 1] : cs1[2 * (j - 2) + 1];
                    o1[j] = x1 * cc - x2 * sn; o2[j] = x2 * cc + x1 * sn; }
                st4(dst + 64 + i, o1[0], o1[1], o1[2], o1[3]); st4(dst + 80 + i, o2[0], o2[1], o2[2], o2[3]); } }
    }
};

struct EpiUkv {
    static constexpr bool FULL = false;
    bf16_t *mk, *mvT; const bf16_t* zc; const float* kn; const f32x2* rope16;
    __device__ __forceinline__ void operator()(f32x16 (&acc)[2][2], const TileCtx& c, char*) const {
        const int fw = c.f0 + c.wm * 64;
        if (fw < 384) { const int head = fw >> 6;
#pragma unroll
            for (int nt = 0; nt < 2; ++nt) { const int t = c.tok0 + c.wn * 64 + nt * 32 + c.l31; const float rs = c.rs[nt]; float ss = 0.f;
#pragma unroll
                for (int mt = 0; mt < 2; ++mt)
#pragma unroll
                    for (int r = 0; r < 16; ++r) { const float v = acc[mt][nt][r] * rs; acc[mt][nt][r] = v; ss += v * v; }
                const bf16_t* krp = zc + (size_t)t * 416 + 384 + 8 * c.hh; const u32x4 ka = *(const u32x4*)krp, kb = *(const u32x4*)(krp + 16);
                float x1[8], x2[8];
#pragma unroll
                for (int e = 0; e < 4; ++e) { x1[2 * e] = bflo(ka[e]); x1[2 * e + 1] = bfhi(ka[e]); x2[2 * e] = bflo(kb[e]); x2[2 * e + 1] = bfhi(kb[e]); }
#pragma unroll
                for (int e = 0; e < 8; ++e) ss += x1[e] * x1[e] + x2[e] * x2[e];
                ss += __shfl_xor(ss, 32); const float rq = rsqrtf(ss * (1.f / 96.f) + EPS);
                int sbase, S; tokinfo(t, sbase, S); const int pos = t - sbase; bf16_t* dst = mk + (size_t)t * 576 + head * 96;
#pragma unroll
                for (int mt = 0; mt < 2; ++mt)
#pragma unroll
                    for (int g = 0; g < 4; ++g) { const int d = mt * 32 + 8 * g + 4 * c.hh; const f32x4 gn = *(const f32x4*)(kn + d);
                        st4(dst + d, acc[mt][nt][4 * g] * rq * gn[0], acc[mt][nt][4 * g + 1] * rq * gn[1], acc[mt][nt][4 * g + 2] * rq * gn[2], acc[mt][nt][4 * g + 3] * rq * gn[3]); }
                float o1[8], o2[8];
#pragma unroll
                for (int e = 0; e < 8; ++e) { const int i = 8 * c.hh + e; const f32x2 cs = rope16[pos * 16 + i]; const float a = x1[e] * rq * kn[64 + i], b = x2[e] * rq * kn[80 + i];
                    o1[e] = a * cs[0] - b * cs[1]; o2[e] = b * cs[0] + a * cs[1]; }
                u32x4 w1 = {pk2(o1[0], o1[1]), pk2(o1[2], o1[3]), pk2(o1[4], o1[5]), pk2(o1[6], o1[7])}, w2 = {pk2(o2[0], o2[1]), pk2(o2[2], o2[3]), pk2(o2[4], o2[5]), pk2(o2[6], o2[7])};
                *(u32x4*)(dst + 64 + 8 * c.hh) = w1; *(u32x4*)(dst + 80 + 8 * c.hh) = w2; }
        } else { const int head = (fw - 384) >> 6;
#pragma unroll
            for (int nt = 0; nt < 2; ++nt) { const int t = c.tok0 + c.wn * 64 + nt * 32 + c.l31; const float rs = c.rs[nt];
#pragma unroll
                for (int mt = 0; mt < 2; ++mt)
#pragma unroll
                    for (int r = 0; r < 16; ++r) mvT[(size_t)(head * 64 + mt * 32 + crow(r, c.hh)) * TP + t] = f2bf(acc[mt][nt][r] * rs); }
        }
    }
};

struct EpiRes {
    static constexpr bool FULL = false;
    SrcX xin; float* out; bf16_t* xb; float* ssp;
    __device__ __forceinline__ void operator()(f32x16 (&acc)[2][2], const TileCtx& c, char* lds) const {
        float* R = (float*)(lds + c.wid * EPI_WREG);
#pragma unroll
        for (int nt = 0; nt < 2; ++nt)
#pragma unroll
            for (int mt = 0; mt < 2; ++mt)
#pragma unroll
                for (int g = 0; g < 4; ++g) { f32x4 v = {acc[mt][nt][4 * g], acc[mt][nt][4 * g + 1], acc[mt][nt][4 * g + 2], acc[mt][nt][4 * g + 3]}; *(f32x4*)(R + (nt * 32 + c.l31) * 68 + mt * 32 + 8 * g + 4 * c.hh) = v; }
        const int rr = c.lane >> 4, cc = c.lane & 15, fb = c.f0 + c.wm * 64, f = fb + 4 * cc, t0 = c.tok0 + c.wn * 64 + rr;
        const float* xr = xin.row(t0) + f; float* orow = out + (size_t)t0 * 1024 + f; bf16_t* brow = xb + (size_t)t0 * 1024 + f; float* sp = ssp + (size_t)t0 * 16 + (fb >> 6);
        const float* Rr = R + rr * 68 + 4 * cc;
#pragma unroll 4
        for (int i = 0; i < 16; ++i) { f32x4 v = *(const f32x4*)Rr; const f32x4 xv = *(const f32x4*)xr; v[0] += xv[0]; v[1] += xv[1]; v[2] += xv[2]; v[3] += xv[3];
            *(f32x4*)orow = v; st4(brow, v[0], v[1], v[2], v[3]);
            float ss = v[0] * v[0] + v[1] * v[1] + v[2] * v[2] + v[3] * v[3];
            ss += __shfl_xor(ss, 1); ss += __shfl_xor(ss, 2); ss += __shfl_xor(ss, 4); ss += __shfl_xor(ss, 8);
            if (cc == 0) *sp = ss;
            Rr += 4 * 68; xr += 4096; orow += 4096; brow += 4096; sp += 64; }
    }
};

struct EpiQLds {
    static constexpr bool FULL = true;
    __device__ __forceinline__ void operator()(f32x16 (&acc)[4][2], const TileCtx& c, char* lds) const {
#pragma unroll
        for (int nt = 0; nt < 2; ++nt) { const int row = c.wn * 64 + nt * 32 + c.l31; const float rs = c.rs[nt];
#pragma unroll
            for (int mt = 0; mt < 4; ++mt)
#pragma unroll
                for (int g = 0; g < 4; ++g) { const int chunk = c.wm * 16 + mt * 4 + g;
                    st4((bf16_t*)(lds + row * 512 + ((chunk ^ (row & 15)) << 4) + 8 * c.hh), acc[mt][nt][4 * g] * rs, acc[mt][nt][4 * g + 1] * rs, acc[mt][nt][4 * g + 2] * rs, acc[mt][nt][4 * g + 3] * rs); } }
    }
};
struct EpiNull {
    static constexpr bool FULL = true; float* out;
    __device__ __forceinline__ void operator()(f32x16 (&acc)[4][2], const TileCtx& c, char*) const { float a = 0.f;
#pragma unroll
        for (int i = 0; i < 4; ++i)
#pragma unroll
            for (int j = 0; j < 2; ++j)
#pragma unroll
                for (int r = 0; r < 16; ++r) a += acc[i][j][r];
        if (a == 12345.678f) out[c.l31] = a; }
};
struct EpiBf {
    static constexpr bool FULL = false;
    bf16_t* dst; int ld;
    __device__ __forceinline__ void operator()(f32x16 (&acc)[2][2], const TileCtx& c, char* lds) const {
#pragma unroll
        for (int nt = 0; nt < 2; ++nt)
#pragma unroll
            for (int mt = 0; mt < 2; ++mt)
#pragma unroll
                for (int r = 0; r < 16; ++r) acc[mt][nt][r] *= c.rs[nt];
        bf16_t* base = dst + (size_t)(c.tok0 + c.wn * 64) * ld + c.f0 + c.wm * 64; const int ld_ = ld;
        put_rows_bf16(lds, c, acc, 8, [&](int tl) { return base + (size_t)tl * ld_; });
    }
};

struct EpiMem {
    static constexpr bool FULL = true;
    bf16_t *memK, *memVT; const float *xkn, *xqn;
    __device__ __forceinline__ void operator()(f32x16 (&acc)[4][2], const TileCtx& c, char* lds) const {
        const int mb = c.tok0 + c.wn * 64;
        if (c.f0 < 1024) { float* ssx = (float*)(lds + LDS_SSX);
#pragma unroll
            for (int nt = 0; nt < 2; ++nt) { float ss = 0.f;
#pragma unroll
                for (int mt = 0; mt < 4; ++mt)
#pragma unroll
                    for (int r = 0; r < 16; ++r) { const float v = acc[mt][nt][r] * c.rs[nt]; acc[mt][nt][r] = v; ss += v * v; }
                ss += __shfl_xor(ss, 32); if (c.hh == 0) ssx[c.wm * 256 + c.wn * 64 + nt * 32 + c.l31] = ss; }
            __syncthreads();
            float rk[2];
#pragma unroll
            for (int nt = 0; nt < 2; ++nt) { const int tl = c.wn * 64 + nt * 32 + c.l31; rk[nt] = rsqrtf((ssx[tl] + ssx[256 + tl]) * (1.f / 256.f) + EPS) * 0.0625f; }
            bf16_t* base = memK + (size_t)mb * 1024 + c.f0 + c.wm * 128;
#pragma unroll
            for (int hf = 0; hf < 2; ++hf) {
#pragma unroll
                for (int m2 = 0; m2 < 2; ++m2)
#pragma unroll
                    for (int g = 0; g < 4; ++g) { const int mt = 2 * hf + m2, d = c.wm * 128 + mt * 32 + 8 * g + 4 * c.hh; const f32x4 gk = *(const f32x4*)(xkn + d), gq = *(const f32x4*)(xqn + d);
#pragma unroll
                        for (int j = 0; j < 4; ++j) { acc[mt][0][4 * g + j] *= rk[0] * gk[j] * gq[j]; acc[mt][1][4 * g + j] *= rk[1] * gk[j] * gq[j]; } }
                bf16_t* bh = base + hf * 64;
                put_rows_bf16(lds, c, *(f32x16(*)[2][2])&acc[2 * hf], 8, [&](int tl) { return bh + (size_t)tl * 1024; });
                asm volatile("" ::: "memory");
            }
        } else {
#pragma unroll
            for (int nt = 0; nt < 2; ++nt) { const int m = mb + nt * 32 + c.l31, b = m >> 8, key = m & 255; const float rs = c.rs[nt];
#pragma unroll
                for (int mt = 0; mt < 4; ++mt)
#pragma unroll
                    for (int r = 0; r < 16; ++r) memVT[((size_t)(b * 1024 + c.f0 - 1024 + c.wm * 128 + mt * 32 + crow(r, c.hh)) << 8) + key] = f2bf(acc[mt][nt][r] * rs); }
        }
    }
};

struct EpiFfn {
    static constexpr bool FULL = true;
    bf16_t* act; const float *cw, *cb; int sbase, S, pos0, ft;
    __device__ __forceinline__ void operator()(f32x16 (&acc)[4][2], const TileCtx& c, char* lds) const {
        float* U = (float*)lds;
        const int tid = otid(), f = tid & 63, tq = tid >> 6;
#pragma unroll
        for (int ps = 0; ps < 2; ++ps) {
#pragma unroll
            for (int nt = 0; nt < 2; ++nt) { const int tl = c.wn * 64 + nt * 32 + c.l31; const float rs = ((unsigned)(pos0 + tl) < (unsigned)S) ? c.rs[nt] : 0.f;
#pragma unroll
                for (int mt = 0; mt < 2; ++mt)
#pragma unroll
                    for (int r = 0; r < 16; ++r) U[tl * 129 + c.wm * 64 + mt * 32 + crow(r, c.hh)] = acc[2 * ps + mt][nt][r] * rs; }
            __syncthreads();
            { const int fa = ft * 128 + ps * 64 + f, fg = 2816 + fa;
              const float a0 = cw[fa], a1 = cw[5632 + fa], a2 = cw[2 * 5632 + fa], ab = cb[fa], g0 = cw[fg], g1 = cw[5632 + fg], g2 = cw[2 * 5632 + fg], gb = cb[fg];
              const int i0 = 1 + tq * 32; int i1 = i0 + 32; if (i1 > 255) i1 = 255;
              float pa = U[(i0 - 1) * 129 + f], ca = U[i0 * 129 + f], pg = U[(i0 - 1) * 129 + 64 + f], cg_ = U[i0 * 129 + 64 + f];
              const float* up = U + (i0 + 1) * 129 + f; bf16_t* ap = act + (size_t)(sbase + pos0 + i0) * 2816 + fa; int lim = S - (pos0 + i0); lim = lim < i1 - i0 ? lim : i1 - i0;
              for (int i = 0; i < lim; ++i) { const float na = up[0], ng = up[64]; up += 129;
                  const float ua = a0 * pa + a1 * ca + a2 * na + ab, ug = g0 * pg + g1 * cg_ + g2 * ng + gb;
                  const float y = ua * ug * __builtin_amdgcn_rcpf(1.f + __builtin_amdgcn_exp2f(-1.4426950408889634f * ug));
                  *ap = f2bf(y); ap += 2816;
                  pa = ca; ca = na; pg = cg_; cg_ = ng; } }
            __syncthreads();
        }
    }
};

template <int NKS, int NDT, class Hook>
__device__ __forceinline__ void attn_wave(const bf16_t* __restrict__ qrow, const bf16_t* __restrict__ kb, const int kstride, const bf16_t* __restrict__ vT, const size_t vstride,
                                          const int sub_lo, const int sub_hi, Hook& hook, f32x16 (&O)[NDT], float& m_out, float& l_out) {
    const int lane = otid() & 63, l31 = lane & 31, hh = lane >> 5;
    bf16x8 qf[NKS];
#pragma unroll
    for (int ks = 0; ks < NKS; ++ks) qf[ks] = *(const bf16x8*)(qrow + ks * 16 + hh * 8);
    float m = -1e30f, lsum = 0.f;
#pragma unroll
    for (int dt = 0; dt < NDT; ++dt)
#pragma unroll
        for (int r = 0; r < 16; ++r) O[dt][r] = 0.f;
    bf16x8 kn[NKS]; s16x4 vn[NDT][4]; float bn[16];
#define AW_LOAD(sub_) do { const bf16_t* kp_ = kb + (size_t)((sub_) * 32 + l31) * kstride + hh * 8;                                        \
        _Pragma("unroll") for (int ks = 0; ks < NKS; ++ks) kn[ks] = *(const bf16x8*)(kp_ + ks * 16);                                       \
        _Pragma("unroll") for (int dt = 0; dt < NDT; ++dt) { const bf16_t* vp_ = vT + (size_t)(dt * 32 + l31) * vstride + (sub_) * 32 + hh * 4; \
            vn[dt][0] = *(const s16x4*)vp_; vn[dt][1] = *(const s16x4*)(vp_ + 8); vn[dt][2] = *(const s16x4*)(vp_ + 16); vn[dt][3] = *(const s16x4*)(vp_ + 24); } \
        hook.load(bn, (sub_)); } while (0)
    AW_LOAD(sub_lo);
    for (int sub = sub_lo; sub < sub_hi; ++sub) {
        bf16x8 kc[NKS]; s16x4 vc[NDT][4]; float bc[16];
#pragma unroll
        for (int ks = 0; ks < NKS; ++ks) kc[ks] = kn[ks];
#pragma unroll
        for (int dt = 0; dt < NDT; ++dt)
#pragma unroll
            for (int i = 0; i < 4; ++i) vc[dt][i] = vn[dt][i];
#pragma unroll
        for (int r = 0; r < 16; ++r) bc[r] = bn[r];
        if (sub + 1 < sub_hi) AW_LOAD(sub + 1);
        f32x16 s;
#pragma unroll
        for (int r = 0; r < 16; ++r) s[r] = 0.f;
#pragma unroll
        for (int ks = 0; ks < NKS; ++ks) s = MFMA32(kc[ks], qf[ks], s);
        hook.apply(s, sub, bc);
        float mx = s[0];
#pragma unroll
        for (int r = 1; r < 16; ++r) mx = fmaxf(mx, s[r]);
        mx = fmaxf(mx, __shfl_xor(mx, 32));
        const float mn = fmaxf(m, mx), alpha = __builtin_amdgcn_exp2f(m - mn); m = mn;
        float ps = 0.f;
#pragma unroll
        for (int r = 0; r < 16; ++r) { s[r] = __builtin_amdgcn_exp2f(s[r] - mn); ps += s[r]; }
        lsum = lsum * alpha + ps;
        u32x4 w0 = {pk2(s[0], s[1]), pk2(s[2], s[3]), pk2(s[4], s[5]), pk2(s[6], s[7])}, w1 = {pk2(s[8], s[9]), pk2(s[10], s[11]), pk2(s[12], s[13]), pk2(s[14], s[15])};
        const bf16x8 pf0 = *(bf16x8*)&w0, pf1 = *(bf16x8*)&w1;
#pragma unroll
        for (int dt = 0; dt < NDT; ++dt) {
#pragma unroll
            for (int r = 0; r < 16; ++r) O[dt][r] *= alpha;
            const bf16x8 va = {vc[dt][0][0], vc[dt][0][1], vc[dt][0][2], vc[dt][0][3], vc[dt][1][0], vc[dt][1][1], vc[dt][1][2], vc[dt][1][3]},
                         vb = {vc[dt][2][0], vc[dt][2][1], vc[dt][2][2], vc[dt][2][3], vc[dt][3][0], vc[dt][3][1], vc[dt][3][2], vc[dt][3][3]};
            O[dt] = MFMA32(va, pf0, O[dt]); O[dt] = MFMA32(vb, pf1, O[dt]);
        }
    }
#undef AW_LOAD
    l_out = lsum + __shfl_xor(lsum, 32); m_out = m;
}
template <int NDT>
__device__ __forceinline__ void attn_store(bf16_t* orow, const f32x16 (&O)[NDT], float l) {
    const int hh = (otid() & 63) >> 5; const float inv = 1.f / l;
#pragma unroll
    for (int dt = 0; dt < NDT; ++dt)
#pragma unroll
        for (int g = 0; g < 4; ++g) st4(orow + dt * 32 + 8 * g + 4 * hh, O[dt][4 * g] * inv, O[dt][4 * g + 1] * inv, O[dt][4 * g + 2] * inv, O[dt][4 * g + 3] * inv);
}

struct HookNA { const float* rpb; int c, cs, joff, hh;
    __device__ __forceinline__ void load(float (&b)[16], int sub) const { const int j = sub >> 1, cb = (sub & 1) * 32; const float* row = rpb + (joff + j) * 31 + 15 - c;
#pragma unroll
        for (int r = 0; r < 16; ++r) { const int col = cb + crow(r, hh); b[r] = ((unsigned)(col - cs) < 16u) ? row[col] : -1e30f; } }
    __device__ __forceinline__ void apply(f32x16& s, int, const float (&b)[16]) const {
#pragma unroll
        for (int r = 0; r < 16; ++r) s[r] = b[r] > -1e29f ? (s[r] * 0.125f + b[r]) * LOG2E : -1e30f; } };
struct HookDil { int qv, hh;
    __device__ __forceinline__ void load(float (&)[16], int) const {}
    __device__ __forceinline__ void apply(f32x16& s, int sub, const float (&)[16]) const {
#pragma unroll
        for (int r = 0; r < 16; ++r) { int d = sub * 32 + crow(r, hh) - qv; d = d < 0 ? -d : d; s[r] = d <= 64 ? s[r] * (0.125f * LOG2E) : -1e30f; } } };

#define PK4(P, BASE, OUT) do { const unsigned a0_ = pk2(P[BASE + 0], P[BASE + 1]), a1_ = pk2(P[BASE + 2], P[BASE + 3]), b0_ = pk2(P[BASE + 4], P[BASE + 5]), b1_ = pk2(P[BASE + 6], P[BASE + 7]); \
        const auto r0_ = __builtin_amdgcn_permlane32_swap(a0_, b0_, false, false); const auto r1_ = __builtin_amdgcn_permlane32_swap(a1_, b1_, false, false);                              \
        u32x4 w_ = {r0_[0], r1_[0], r0_[1], r1_[1]}; OUT = *(bf16x8*)&w_; } while (0)
__device__ __forceinline__ void dense_item(bf16_t* qrow, const bf16_t* __restrict__ kb, const bf16_t* __restrict__ vT, const int nt, const float sc, char* lds) {
    const int tid = otid(), lane = tid & 63, wid = tid >> 6, l31 = lane & 31, hh = lane >> 5;
    int off[3];
#pragma unroll
    for (int j = 0; j < 3; ++j) { const int pc = wid + 8 * j;
        if (pc < 12) { const int b = pc * 1024 + lane * 16, r = b / 192, cp = (b - r * 192) >> 4, c = (cp & ~3) | ((cp & 3) ^ ((r >> 2) & 3)); off[j] = r * 576 + c * 8; }
        else { const int r = (pc - 12) * 8 + (lane >> 3), p = (lane & 7) ^ ((r >> 1) & 7); off[j] = r * TP + p * 8; } }
    const bool three = wid < 4;
#define DPIECE(j_, st_, t_) do { const int pc_ = wid + 8 * (j_); const bf16_t* g_ = pc_ < 12 ? kb + (size_t)(t_) * (64 * 576) + off[j_] : vT + (t_) * 64 + off[j_]; GLDS(g_, lds + (st_) * 20480 + pc_ * 1024); } while (0)
#define DSTAGE(st_, t_) do { DPIECE(0, st_, t_); DPIECE(1, st_, t_); if (three) DPIECE(2, st_, t_); } while (0)
#define DWAIT1() do { if (three) WAIT_V(3); else WAIT_V(2); } while (0)
#define DWAIT2() do { if (three) WAIT_V(6); else WAIT_V(4); } while (0)
    DSTAGE(0, 0); if (nt > 1) DSTAGE(1, 1); if (nt > 2) DSTAGE(2, 2);
    bf16x8 qf[6];
#pragma unroll
    for (int ks = 0; ks < 6; ++ks) qf[ks] = *(const bf16x8*)(qrow + ks * 16 + hh * 8);
    const int x = (l31 >> 2) & 3, y = (l31 >> 1) & 7;
    int kfo[6], vfo[4];
#pragma unroll
    for (int ks = 0; ks < 6; ++ks) { const int c = 2 * ks + hh; kfo[ks] = l31 * 192 + (((c & ~3) | ((c & 3) ^ x)) << 4); }
#pragma unroll
    for (int pp = 0; pp < 4; ++pp) vfo[pp] = 12288 + l31 * 128 + (((2 * pp + hh) ^ y) << 4);
    float m = -1e30f, lsum = 0.f; f32x16 O0, O1, s0, s1;
#pragma unroll
    for (int r = 0; r < 16; ++r) { O0[r] = 0.f; O1[r] = 0.f; s0[r] = 0.f; s1[r] = 0.f; }
    if (nt > 2) DWAIT2(); else if (nt > 1) DWAIT1(); else WAIT_V(0);
    RAW_BARRIER();
#pragma unroll
    for (int ks = 0; ks < 6; ++ks) { s0 = MFMA32(*(const bf16x8*)(lds + kfo[ks]), qf[ks], s0); s1 = MFMA32(*(const bf16x8*)(lds + kfo[ks] + 6144), qf[ks], s1); }
#define SNEXT(ks_, m_) do { if (m_) { n0 = MFMA32(*(const bf16x8*)(sn + kfo[ks_]), qf[ks_], n0); n1 = MFMA32(*(const bf16x8*)(sn + kfo[ks_] + 6144), qf[ks_], n1); } } while (0)
#define TILE_BODY(MORE_) do { \
        const char* sb = lds + (t & 3) * 20480; const char* sn = lds + ((t + 1) & 3) * 20480; \
        f32x16 n0, n1; \
_Pragma("unroll")         for (int r = 0; r < 16; ++r) { n0[r] = 0.f; n1[r] = 0.f; } \
        SNEXT(0, MORE_); \
        float mx = s0[0]; \
_Pragma("unroll")         for (int r = 0; r < 8; ++r) mx = vmax3(mx, s0[r], s1[r]); \
        SNEXT(1, MORE_); \
_Pragma("unroll")         for (int r = 8; r < 16; ++r) mx = vmax3(mx, s0[r], s1[r]); \
        mx = fmaxf(mx, __shfl_xor(mx, 32)) * sc; \
        const float mn = fmaxf(m, mx), alpha = __builtin_amdgcn_exp2f(m - mn); m = mn; \
        SNEXT(2, MORE_); \
        float ps = 0.f; \
_Pragma("unroll")         for (int r = 0; r < 8; ++r) { s0[r] = __builtin_amdgcn_exp2f(fmaf(s0[r], sc, -mn)); s1[r] = __builtin_amdgcn_exp2f(fmaf(s1[r], sc, -mn)); ps += s0[r] + s1[r]; } \
        SNEXT(3, MORE_); \
_Pragma("unroll")         for (int r = 8; r < 16; ++r) { s0[r] = __builtin_amdgcn_exp2f(fmaf(s0[r], sc, -mn)); s1[r] = __builtin_amdgcn_exp2f(fmaf(s1[r], sc, -mn)); ps += s0[r] + s1[r]; } \
        lsum = lsum * alpha + ps; \
        SNEXT(4, MORE_); \
        bf16x8 pf0, pf1, pf2, pf3; PK4(s0, 0, pf0); PK4(s0, 8, pf1); \
        SNEXT(5, MORE_); \
        PK4(s1, 0, pf2); PK4(s1, 8, pf3); \
_Pragma("unroll")         for (int r = 0; r < 16; ++r) { O0[r] *= alpha; O1[r] *= alpha; } \
        O0 = MFMA32(*(const bf16x8*)(sb + vfo[0]), pf0, O0); O1 = MFMA32(*(const bf16x8*)(sb + vfo[0] + 4096), pf0, O1); \
        O0 = MFMA32(*(const bf16x8*)(sb + vfo[1]), pf1, O0); O1 = MFMA32(*(const bf16x8*)(sb + vfo[1] + 4096), pf1, O1); \
        O0 = MFMA32(*(const bf16x8*)(sb + vfo[2]), pf2, O0); O1 = MFMA32(*(const bf16x8*)(sb + vfo[2] + 4096), pf2, O1); \
        O0 = MFMA32(*(const bf16x8*)(sb + vfo[3]), pf3, O0); O1 = MFMA32(*(const bf16x8*)(sb + vfo[3] + 4096), pf3, O1); \
        s0 = n0; s1 = n1; } while (0)
    for (int t = 0; t + 1 < nt; ++t) {
        if (t + 2 < nt) DWAIT1(); else WAIT_V(0);
        RAW_BARRIER();
        if (t + 3 < nt) DSTAGE((t + 3) & 3, t + 3);
        TILE_BODY(true);
    }
    { const int t = nt - 1; TILE_BODY(false); }
#undef TILE_BODY
#undef SNEXT
#undef DSTAGE
#undef DPIECE
#undef DWAIT1
#undef DWAIT2
    RAW_BARRIER();
    const float inv = 1.f / (lsum + __shfl_xor(lsum, 32));
#pragma unroll
    for (int g = 0; g < 4; ++g) { st4(qrow + 8 * g + 4 * hh, O0[4 * g] * inv, O0[4 * g + 1] * inv, O0[4 * g + 2] * inv, O0[4 * g + 3] * inv);
        st4(qrow + 32 + 8 * g + 4 * hh, O1[4 * g] * inv, O1[4 * g + 1] * inv, O1[4 * g + 2] * inv, O1[4 * g + 3] * inv); }
}

__device__ __forceinline__ void na_item(bf16_t* naq, const bf16_t* __restrict__ nak, const bf16_t* __restrict__ navT, const float* __restrict__ rpbh, const int tR0, const int head, char* lds) {
    const int tid = otid(), lane = tid & 63, wid = tid >> 6, l31 = lane & 31, hh = lane >> 5;
    int sbase, S; tokinfo(tR0, sbase, S); const int rows = S >> 6, r0 = (tR0 - sbase) >> 6;
    int rs0 = r0 - 4; rs0 = rs0 < 0 ? 0 : rs0; rs0 = rs0 > rows - 8 ? rows - 8 : rs0;
    int rs3 = r0 - 1; rs3 = rs3 < 0 ? 0 : rs3; rs3 = rs3 > rows - 8 ? rows - 8 : rs3;
    const int nch = rs3 - rs0 + 8, ri = r0 + (wid >> 1);
    int rsi = ri - 4; rsi = rsi < 0 ? 0 : rsi; rsi = rsi > rows - 8 ? rows - 8 : rsi;
    const int jlo = __builtin_amdgcn_readfirstlane(rsi - rs0);
    const int c = (wid & 1) * 32 + l31; int cs = c - 8; cs = cs < 0 ? 0 : cs; cs = cs > 48 ? 48 : cs;
    const int sr = 8 * wid + (lane >> 3), sc8 = ((lane & 7) ^ ((sr >> 1) & 7)) * 8;
    const bf16_t* ksrc = nak + (size_t)(sbase + rs0 * 64 + sr) * 384 + head * 64 + sc8;
    const bf16_t* vsrc = navT + (size_t)(head * 64 + sr) * TP + sbase + rs0 * 64 + sc8;
#define NSTAGE(slot_, j_) do { GLDS(ksrc + (size_t)(j_) * (64 * 384), lds + (slot_) * 16384 + wid * 1024); GLDS(vsrc + (j_) * 64, lds + (slot_) * 16384 + 8192 + wid * 1024); } while (0)
    float* tab = (float*)(lds + 65536);
    if (tid < 465) tab[tid] = rpbh[tid];
    NSTAGE(0, 0); NSTAGE(1, 1); NSTAGE(2, 2);
    bf16_t* qrow = naq + (size_t)(tR0 + (wid >> 1) * 64 + c) * 384 + head * 64;
    bf16x8 qf[4];
#pragma unroll
    for (int ks = 0; ks < 4; ++ks) qf[ks] = *(const bf16x8*)(qrow + ks * 16 + hh * 8);
    const int y = (l31 >> 1) & 7;
    int fo[4];
#pragma unroll
    for (int k = 0; k < 4; ++k) fo[k] = l31 * 128 + (((2 * k + hh) ^ y) << 4);
    float m = -1e30f, lsum = 0.f; f32x16 O0, O1;
#pragma unroll
    for (int r = 0; r < 16; ++r) { O0[r] = 0.f; O1[r] = 0.f; }
    for (int j = 0; j < nch; ++j) {
        if (j + 2 < nch) WAIT_V(4); else if (j + 1 < nch) WAIT_V(2); else WAIT_V(0);
        RAW_BARRIER();
        if (j + 3 < nch) NSTAGE((j + 3) & 3, j + 3);
        if (j >= jlo && j < jlo + 8) {
            const char* sb = lds + (j & 3) * 16384;
            f32x16 s0, s1;
#pragma unroll
            for (int r = 0; r < 16; ++r) { s0[r] = 0.f; s1[r] = 0.f; }
#pragma unroll
            for (int ks = 0; ks < 4; ++ks) { s0 = MFMA32(*(const bf16x8*)(sb + fo[ks]), qf[ks], s0); s1 = MFMA32(*(const bf16x8*)(sb + fo[ks] + 4096), qf[ks], s1); }
            const int base = (rs0 + j - ri + 7) * 31 + 15 - c;
#pragma unroll
            for (int r = 0; r < 16; ++r) { const int c0 = crow(r, hh), c1 = 32 + c0; const bool v0 = (unsigned)(c0 - cs) < 16u, v1 = (unsigned)(c1 - cs) < 16u;
                const float b0 = tab[v0 ? base + c0 : 0], b1 = tab[v1 ? base + c1 : 0];
                s0[r] = v0 ? (s0[r] * 0.125f + b0) * LOG2E : -1e30f; s1[r] = v1 ? (s1[r] * 0.125f + b1) * LOG2E : -1e30f; }
            float mx = s0[0];
#pragma unroll
            for (int r = 0; r < 16; ++r) mx = vmax3(mx, s0[r], s1[r]);
            mx = fmaxf(mx, __shfl_xor(mx, 32));
            const float mn = fmaxf(m, mx), alpha = __builtin_amdgcn_exp2f(m - mn); m = mn;
            float ps = 0.f;
#pragma unroll
            for (int r = 0; r < 16; ++r) { s0[r] = __builtin_amdgcn_exp2f(s0[r] - mn); s1[r] = __builtin_amdgcn_exp2f(s1[r] - mn); ps += s0[r] + s1[r]; }
            lsum = lsum * alpha + ps;
            bf16x8 pf0, pf1, pf2, pf3; PK4(s0, 0, pf0); PK4(s0, 8, pf1); PK4(s1, 0, pf2); PK4(s1, 8, pf3);
#pragma unroll
            for (int r = 0; r < 16; ++r) { O0[r] *= alpha; O1[r] *= alpha; }
            const char* sv = sb + 8192;
            O0 = MFMA32(*(const bf16x8*)(sv + fo[0]), pf0, O0); O1 = MFMA32(*(const bf16x8*)(sv + fo[0] + 4096), pf0, O1);
            O0 = MFMA32(*(const bf16x8*)(sv + fo[1]), pf1, O0); O1 = MFMA32(*(const bf16x8*)(sv + fo[1] + 4096), pf1, O1);
            O0 = MFMA32(*(const bf16x8*)(sv + fo[2]), pf2, O0); O1 = MFMA32(*(const bf16x8*)(sv + fo[2] + 4096), pf2, O1);
            O0 = MFMA32(*(const bf16x8*)(sv + fo[3]), pf3, O0); O1 = MFMA32(*(const bf16x8*)(sv + fo[3] + 4096), pf3, O1);
        }
    }
#undef NSTAGE
    RAW_BARRIER();
    const float inv = 1.f / (lsum + __shfl_xor(lsum, 32));
#pragma unroll
    for (int g = 0; g < 4; ++g) { st4(qrow + 8 * g + 4 * hh, O0[4 * g] * inv, O0[4 * g + 1] * inv, O0[4 * g + 2] * inv, O0[4 * g + 3] * inv);
        st4(qrow + 32 + 8 * g + 4 * hh, O1[4 * g] * inv, O1[4 * g + 1] * inv, O1[4 * g + 2] * inv, O1[4 * g + 3] * inv); }
}

__device__ __forceinline__ void dil_item(bf16_t* dq, const bf16_t* __restrict__ dk, const bf16_t* __restrict__ dvT, float* lse, const int tp0, const int h12, char* lds) {
    const int tid = otid(), lane = tid & 63, wid = tid >> 6, l31 = lane & 31, hh = lane >> 5, g = h12 >> 2;
    int sbase, S; tokinfo(tp0, sbase, S); const int L = S >> (2 * g);
    const int tpw = tp0 + 32 * wid, rho = (tpw - sbase) / L, vsb = sbase + rho * L, cb = tp0 - 64;
    const int sr = 8 * wid + (lane >> 3), sc8 = ((lane & 7) ^ ((sr >> 1) & 7)) * 8;
#define DLSTAGE(slot_, j_) do { int cj_ = cb + 64 * (j_); cj_ = cj_ < 0 ? 0 : (cj_ > T - 64 ? T - 64 : cj_);                                                        \
        GLDS(dk + (size_t)(cj_ + sr) * 768 + h12 * 64 + sc8, lds + (slot_) * 16384 + wid * 1024);                                                                    \
        GLDS(dvT + (size_t)(h12 * 64 + sr) * TP + cj_ + sc8, lds + (slot_) * 16384 + 8192 + wid * 1024); } while (0)
    DLSTAGE(0, 0); DLSTAGE(1, 1); DLSTAGE(2, 2);
    bf16_t* qrow = dq + (size_t)(tpw + l31) * 768 + h12 * 64;
    bf16x8 qf[4];
#pragma unroll
    for (int ks = 0; ks < 4; ++ks) qf[ks] = *(const bf16x8*)(qrow + ks * 16 + hh * 8);
    const int y = (l31 >> 1) & 7, qp = tpw + l31, jlo = __builtin_amdgcn_readfirstlane(wid >> 1);
    int fo[4];
#pragma unroll
    for (int k = 0; k < 4; ++k) fo[k] = l31 * 128 + (((2 * k + hh) ^ y) << 4);
    float m = -1e30f, lsum = 0.f; f32x16 O0, O1;
#pragma unroll
    for (int r = 0; r < 16; ++r) { O0[r] = 0.f; O1[r] = 0.f; }
    for (int j = 0; j < 6; ++j) {
        if (j + 2 < 6) WAIT_V(4); else if (j + 1 < 6) WAIT_V(2); else WAIT_V(0);
        RAW_BARRIER();
        if (j + 3 < 6) DLSTAGE((j + 3) & 3, j + 3);
        const int kb0 = __builtin_amdgcn_readfirstlane(cb + 64 * j);
        if (j >= jlo && j <= jlo + 2 && kb0 + 64 > vsb && kb0 < vsb + L) {
            const char* sb = lds + (j & 3) * 16384;
            f32x16 s0, s1;
#pragma unroll
            for (int r = 0; r < 16; ++r) { s0[r] = 0.f; s1[r] = 0.f; }
#pragma unroll
            for (int ks = 0; ks < 4; ++ks) { s0 = MFMA32(*(const bf16x8*)(sb + fo[ks]), qf[ks], s0); s1 = MFMA32(*(const bf16x8*)(sb + fo[ks] + 4096), qf[ks], s1); }
#pragma unroll
            for (int r = 0; r < 16; ++r) { const int k0 = kb0 + crow(r, hh), k1 = k0 + 32; int d0 = k0 - qp, d1 = k1 - qp; d0 = d0 < 0 ? -d0 : d0; d1 = d1 < 0 ? -d1 : d1;
                s0[r] = (d0 <= 64 && k0 >= vsb && k0 < vsb + L) ? s0[r] * (0.125f * LOG2E) : -1e30f; s1[r] = (d1 <= 64 && k1 >= vsb && k1 < vsb + L) ? s1[r] * (0.125f * LOG2E) : -1e30f; }
            float mx = s0[0];
#pragma unroll
            for (int r = 0; r < 16; ++r) mx = vmax3(mx, s0[r], s1[r]);
            mx = fmaxf(mx, __shfl_xor(mx, 32));
            const float mn = fmaxf(m, mx), alpha = __builtin_amdgcn_exp2f(m - mn); m = mn;
            float ps = 0.f;
#pragma unroll
            for (int r = 0; r < 16; ++r) { s0[r] = __builtin_amdgcn_exp2f(s0[r] - mn); s1[r] = __builtin_amdgcn_exp2f(s1[r] - mn); ps += s0[r] + s1[r]; }
            lsum = lsum * alpha + ps;
            bf16x8 pf0, pf1, pf2, pf3; PK4(s0, 0, pf0); PK4(s0, 8, pf1); PK4(s1, 0, pf2); PK4(s1, 8, pf3);
#pragma unroll
            for (int r = 0; r < 16; ++r) { O0[r] *= alpha; O1[r] *= alpha; }
            const char* sv = sb + 8192;
            O0 = MFMA32(*(const bf16x8*)(sv + fo[0]), pf0, O0); O1 = MFMA32(*(const bf16x8*)(sv + fo[0] + 4096), pf0, O1);
            O0 = MFMA32(*(const bf16x8*)(sv + fo[1]), pf1, O0); O1 = MFMA32(*(const bf16x8*)(sv + fo[1] + 4096), pf1, O1);
            O0 = MFMA32(*(const bf16x8*)(sv + fo[2]), pf2, O0); O1 = MFMA32(*(const bf16x8*)(sv + fo[2] + 4096), pf2, O1);
            O0 = MFMA32(*(const bf16x8*)(sv + fo[3]), pf3, O0); O1 = MFMA32(*(const bf16x8*)(sv + fo[3] + 4096), pf3, O1);
        }
    }
#undef DLSTAGE
    RAW_BARRIER();
    const float ltot = lsum + __shfl_xor(lsum, 32), inv = 1.f / ltot;
#pragma unroll
    for (int gq = 0; gq < 4; ++gq) { st4(qrow + 8 * gq + 4 * hh, O0[4 * gq] * inv, O0[4 * gq + 1] * inv, O0[4 * gq + 2] * inv, O0[4 * gq + 3] * inv);
        st4(qrow + 32 + 8 * gq + 4 * hh, O1[4 * gq] * inv, O1[4 * gq + 1] * inv, O1[4 * gq + 2] * inv, O1[4 * gq + 3] * inv); }
    if (hh == 0) { const int tn = sbase + ((qp - vsb) << (2 * g)) + rho; lse[(size_t)tn * 12 + h12] = (m + __log2f(ltot)) * 0.6931471805599453f; }
}

__device__ __forceinline__ void cross_item(const bf16_t* __restrict__ kh, const bf16_t* __restrict__ vh, bf16_t* orow, char* lds) {
    const int tid = otid(), lane = tid & 63, wid = tid >> 6, l31 = lane & 31, hh = lane >> 5;
    int offK[2], offV[2];
#pragma unroll
    for (int j = 0; j < 2; ++j) { const int pc = wid + 8 * j, r = 2 * pc + (lane >> 5), c = (lane & 31) ^ (r & 15); offK[j] = r * 1024 + c * 8; offV[j] = r * 256 + c * 8; }
#define XSTAGE(slot_, ch_) do { _Pragma("unroll") for (int j_ = 0; j_ < 2; ++j_) { const bf16_t* g_ = (ch_) < 8 ? kh + (size_t)(ch_) * (32 * 1024) + offK[j_] : vh + (size_t)((ch_) - 8) * (32 * 256) + offV[j_];   \
            GLDS(g_, lds + (slot_) * 16384 + (wid + 8 * j_) * 1024); } } while (0)
    bf16x8 qf[16]; float a = 0.f;
    { const int row = wid * 32 + l31; const char* qb = lds + row * 512;
#pragma unroll
      for (int ks = 0; ks < 16; ++ks) { qf[ks] = *(const bf16x8*)(qb + (((2 * ks + hh) ^ (row & 15)) << 4));
#pragma unroll
        for (int e = 0; e < 8; ++e) { const float v = __uint_as_float(((unsigned)(unsigned short)qf[ks][e]) << 16); a += v * v; } } }
    a += __shfl_xor(a, 32); const float rq = rsqrtf(a * (1.f / 256.f) + EPS) * LOG2E;
    RAW_BARRIER();
    XSTAGE(0, 0); XSTAGE(1, 1); XSTAGE(2, 2);
    const int x = l31 & 15, fb = l31 * 512;
    f32x16 s[8]; bf16x8 pf[16]; float linv = 0.f;
#pragma unroll
    for (int ch = 0; ch < 16; ++ch) {
        if (ch + 2 < 16) WAIT_V(4); else if (ch + 1 < 16) WAIT_V(2); else WAIT_V(0);
        RAW_BARRIER();
        if (ch + 3 < 16) XSTAGE((ch + 3) & 3, ch + 3);
        const char* sb = lds + (ch & 3) * 16384 + fb;
        if (ch < 8) {
#pragma unroll
            for (int r = 0; r < 16; ++r) s[ch][r] = 0.f;
#pragma unroll
            for (int ks = 0; ks < 16; ++ks) s[ch] = MFMA32(*(const bf16x8*)(sb + (((2 * ks + hh) ^ x) << 4)), qf[ks], s[ch]);
        } else {
            if (ch == 8) { float mx = s[0][0];
#pragma unroll
                for (int i = 0; i < 8; ++i)
#pragma unroll
                    for (int r = 0; r < 16; r += 2) mx = vmax3(mx, s[i][r], s[i][r + 1]);
                mx = fmaxf(mx, __shfl_xor(mx, 32)) * rq; float ps = 0.f;
#pragma unroll
                for (int i = 0; i < 8; ++i) {
#pragma unroll
                    for (int r = 0; r < 16; ++r) { s[i][r] = __builtin_amdgcn_exp2f(fmaf(s[i][r], rq, -mx)); ps += s[i][r]; }
                    PK4(s[i], 0, pf[2 * i]); PK4(s[i], 8, pf[2 * i + 1]); }
                linv = 1.f / (ps + __shfl_xor(ps, 32)); }
            f32x16 O;
#pragma unroll
            for (int r = 0; r < 16; ++r) O[r] = 0.f;
#pragma unroll
            for (int ks = 0; ks < 16; ++ks) O = MFMA32(*(const bf16x8*)(sb + (((2 * ks + hh) ^ x) << 4)), pf[ks], O);
#pragma unroll
            for (int g = 0; g < 4; ++g) st4(orow + (ch - 8) * 32 + 8 * g + 4 * hh, O[4 * g] * linv, O[4 * g + 1] * linv, O[4 * g + 2] * linv, O[4 * g + 3] * linv);
        }
    }
#undef XSTAGE
    RAW_BARRIER();
}

__device__ __forceinline__ SrcX xsrc(const P& p, int l, bool after_mix) {
    SrcX s; if (l == 0 && !after_mix) { s.p0 = p.xp; s.p1 = p.xs - (size_t)NPR * 1024; s.split = NPR; } else { s.p0 = p.out; s.p1 = p.out; s.split = T; } return s;
}
__device__ __forceinline__ SrcXb xbsrc(char* ws) { SrcXb s; s.xb = (const bf16_t*)(ws + OFF_XB); s.ssp = (const float*)(ws + OFF_SSP); return s; }
__device__ __forceinline__ EpiRes epires(const P& p, char* ws, int l, bool after_mix) {
    EpiRes e; e.xin = xsrc(p, l, after_mix); e.out = p.out; e.xb = (bf16_t*)(ws + OFF_XB); e.ssp = (float*)(ws + OFF_SSP); return e;
}
__device__ __forceinline__ void rowcvt(const float* src, bf16_t* dst, float* ssp16, int lane) {
    const float* s = src + lane * 16; const f32x4 a = *(const f32x4*)s, b = *(const f32x4*)(s + 4), c = *(const f32x4*)(s + 8), d = *(const f32x4*)(s + 12);
    float ss = a[0] * a[0] + a[1] * a[1] + a[2] * a[2] + a[3] * a[3] + b[0] * b[0] + b[1] * b[1] + b[2] * b[2] + b[3] * b[3]
             + c[0] * c[0] + c[1] * c[1] + c[2] * c[2] + c[3] * c[3] + d[0] * d[0] + d[1] * d[1] + d[2] * d[2] + d[3] * d[3];
    u32x4 w0 = {pk2(a[0], a[1]), pk2(a[2], a[3]), pk2(b[0], b[1]), pk2(b[2], b[3])}, w1 = {pk2(c[0], c[1]), pk2(c[2], c[3]), pk2(d[0], d[1]), pk2(d[2], d[3])};
    *(u32x4*)(dst + lane * 16) = w0; *(u32x4*)(dst + lane * 16 + 8) = w1;
    ss += __shfl_xor(ss, 1); ss += __shfl_xor(ss, 2); if ((lane & 3) == 0) ssp16[lane >> 2] = ss;
}

__device__ void phase0(const P& p, char* lds) {
    constexpr unsigned mask = (1u << W_NUM) - 1;
    const int ncv = cvt_count(mask), nrope = 8192 * 48 / 512, nxr = T / 8, nmr = 2560 / 8;
    char* ws = ows(p.ws); const int tid = otid();
    if (blockIdx.x == 0 && tid < 64) ((unsigned*)(ws + OFF_CTR))[tid] = 0u;
    for (int it = blockIdx.x; it < ncv + nrope + nxr + nmr; it += gridDim.x) {
        if (it < ncv) cvt_item(p, 0, mask, it, lds);
        else if (it < ncv + nrope) { const int idx = (it - ncv) * 512 + tid; int pos, i; float inv; f32x2* dst;
            if (idx < 8192 * 32) { pos = idx >> 5; i = idx & 31; inv = p.inv32[i]; dst = (f32x2*)(ws + OFF_ROPE32) + idx; }
            else { const int k = idx - 8192 * 32; pos = k >> 4; i = k & 15; inv = p.inv16[i]; dst = (f32x2*)(ws + OFF_ROPE16) + k; }
            const float ang = (float)pos * inv; const double tr = (double)ang * 0.15915494309189535; const float fr = (float)(tr - rint(tr));
            f32x2 cs = {__builtin_amdgcn_cosf(fr), __builtin_amdgcn_sinf(fr)}; *dst = cs; }
        else if (it < ncv + nrope + nxr) { const int t = (it - ncv - nrope) * 8 + (tid >> 6);
            rowcvt(t < NPR ? p.xp + (size_t)t * 1024 : p.xs + (size_t)(t - NPR) * 1024, (bf16_t*)(ws + OFF_XB) + (size_t)t * 1024, (float*)(ws + OFF_SSP) + (size_t)t * 16, tid & 63); }
        else { const int m = (it - ncv - nrope - nxr) * 8 + (tid >> 6);
            rowcvt(m < 2048 ? p.memp + (size_t)m * 1024 : p.mems + (size_t)(m - 2048) * 1024, (bf16_t*)(ws + OFF_MEMB) + (size_t)m * 1024, (float*)(ws + OFF_MEMSSP) + (size_t)m * 16, tid & 63); }
    }
}

__device__ void phaseA(const P& p, int l, char* lds) {
    const int nin = swz_count(128, 16);
    char* ws = ows(p.ws);
    for (int it = blockIdx.x; it < nin; it += gridDim.x) { int mt, nt; if (!swz(it, 128, 16, mt, nt)) continue;
        EpiIn e; e.zc = (bf16_t*)(ws + OFF_ZC); e.naq = (bf16_t*)(ws + OFF_NAQ); e.nak = (bf16_t*)(ws + OFF_NAK); e.navT = (bf16_t*)(ws + OFF_NAVT);
        e.dq = (bf16_t*)(ws + OFF_DQ); e.dk = (bf16_t*)(ws + OFF_DK); e.dvT = (bf16_t*)(ws + OFF_DVT); e.zss = (float*)(ws + OFF_ZSS);
        e.na_qn = p.na_qn + l * 64; e.na_kn = p.na_kn + l * 64; e.dil_qn = p.dil_qn + l * 64; e.dil_kn = p.dil_kn + l * 64; e.rope32 = (const f32x2*)(ws + OFF_ROPE32);
        gemm_tile(xbsrc(ws), (const bf16_t*)(ws + OFF_WT_IN), 1024, nt * 256, mt * 256, 0, T, e, lds); }
}

__device__ void phaseB(const P& p, int l, char* lds, const int part = 0) {
    char* ws = ows(p.ws); const int nuq = swz_count(128, 3), nukv = swz_count(128, 3), nna = 768, ndil = 1536;
    const int tid_ = otid(), wid = tid_ >> 6, lane = tid_ & 63, l31 = lane & 31, hh = lane >> 5;
    unsigned* ctr = (unsigned*)(ws + OFF_CTR) + 4 + l; int* slot = (int*)(lds + LDS_BYTES - 16);
    for (;;) {
        if (tid_ == 0) *slot = (int)atomicAdd(ctr, 1u);
        RAW_BARRIER(); const int it0 = *slot; RAW_BARRIER();
        if (it0 >= nuq + nukv + nna + ndil) break;
        const int it = it0 < nna ? nuq + nukv + it0 : (it0 < nna + nuq + nukv ? it0 - nna : it0);
        if (it < nuq) { int mt, nt; if (!swz(it, 128, 3, mt, nt)) continue;
            SrcZ<4> s; s.p = (const bf16_t*)(ws + OFF_ZC); s.zss = (const float*)(ws + OFF_ZSS);
            EpiUq e; e.mq = (bf16_t*)(ws + OFF_MQ); e.qn = p.mla_qn + l * 96; e.rope16 = (const f32x2*)(ws + OFF_ROPE16);
            gemm_tile(s, (const bf16_t*)(ws + OFF_WT_UQ), 256, nt * 256, mt * 256, 0, T, e, lds); }
        else if (it < nuq + nukv) { int mt, nt; if (!swz(it - nuq, 128, 3, mt, nt)) continue;
            SrcZ<2> s; s.p = (const bf16_t*)(ws + OFF_ZC) + 256; s.zss = (const float*)(ws + OFF_ZSS) + 4;
            EpiUkv e; e.mk = (bf16_t*)(ws + OFF_MK); e.mvT = (bf16_t*)(ws + OFF_MVT); e.zc = (const bf16_t*)(ws + OFF_ZC); e.kn = p.mla_kn + l * 96; e.rope16 = (const f32x2*)(ws + OFF_ROPE16);
            gemm_tile(s, (const bf16_t*)(ws + OFF_WT_UKV), 128, nt * 256, mt * 256, 0, T, e, lds); }
        else if (it < nuq + nukv + nna) { const int bi = it - nuq - nukv, rg = bi / 6, head = bi - rg * 6;
            na_item((bf16_t*)(ws + OFF_NAQ), (const bf16_t*)(ws + OFF_NAK), (const bf16_t*)(ws + OFF_NAVT), p.na_rpb + ((size_t)l * 6 + head) * 465, rg * 256, head, lds); }
        else { const int bi = it - nuq - nukv - nna, h12 = bi >> 7, tp0 = (bi & 127) * 256;
            dil_item((bf16_t*)(ws + OFF_DQ), (const bf16_t*)(ws + OFF_DK), (const bf16_t*)(ws + OFF_DVT), (float*)(ws + OFF_LSE), tp0, h12, lds); }
    }
}

__device__ void phaseC(const P& p, int l, char* lds) {
    char* ws = ows(p.ws); const unsigned mask = l < 3 ? ((1u << W_IN) | (1u << W_UQ) | (1u << W_UK) | (1u << W_UV)) : 0u, mask2 = l > 0 ? ((1u << W_DOWN) | (1u << W_CO) | (1u << W_UP) | (1u << W_O) | (1u << W_CQ)) : 0u;
    const int ndense = 768, nmem = swz_count(10, 8), ncomb = 2048, ncv = cvt_count(mask), ncv2 = cvt_count(mask2);
    const int tid_ = otid(), wid = tid_ >> 6, lane = tid_ & 63, l31 = lane & 31;
    unsigned* ctr = (unsigned*)(ws + OFF_CTR) + l; int* slot = (int*)(lds + LDS_BYTES - 16);
    for (;;) {
        if (tid_ == 0) *slot = (int)atomicAdd(ctr, 1u);
        RAW_BARRIER(); const int it = *slot; RAW_BARRIER();
        if (it >= ndense + nmem + ncomb + ncv + ncv2) break;
        if (it < ndense) { int sbase, S, head, qb;
            if (it < 384) { const int sq = it / 192, rem = it - sq * 192; head = rem >> 5; qb = rem & 31; sbase = NPR + sq * 8192; S = 8192; }
            else { const int k = it - 384, sq = k / 48, rem = k - sq * 48; head = rem >> 3; qb = rem & 7; sbase = sq * 2048; S = 2048; }
            bf16_t* mq = (bf16_t*)(ws + OFF_MQ); bf16_t* qrow = mq + (size_t)(sbase + qb * 256 + wid * 32 + l31) * 576 + head * 96;
            dense_item(qrow, (const bf16_t*)(ws + OFF_MK) + (size_t)sbase * 576 + head * 96, (const bf16_t*)(ws + OFF_MVT) + (size_t)(head * 64) * TP + sbase, S >> 6, 0.10206207261596575f * LOG2E, lds); }
        else if (it < ndense + nmem) { int mt, nt; if (swz(it - ndense, 10, 8, mt, nt)) {
            SrcXb s; s.xb = (const bf16_t*)(ws + OFF_MEMB); s.ssp = (const float*)(ws + OFF_MEMSSP);
            EpiMem e; e.memK = (bf16_t*)(ws + OFF_MEMK); e.memVT = (bf16_t*)(ws + OFF_MEMVT); e.xkn = p.x_kn + l * 256; e.xqn = p.x_qn + l * 256;
            gemm_tile(s, (const bf16_t*)(ws + OFF_WT_CKV), 1024, nt * 256, mt * 256, 0, 2560, e, lds); } }
        else if (it < ndense + nmem + ncomb) { const int idx = (it - ndense - nmem) * 512 + tid_, cch = idx & 7, hs = (idx >> 3) & 3, t = idx >> 5;
            const float* lse = (const float*)(ws + OFF_LSE) + (size_t)t * 12 + hs; const float l0 = lse[0], l1 = lse[4], l2 = lse[8];
            const float M = fmaxf(l0, fmaxf(l1, l2)); float w0 = __expf(l0 - M), w1 = __expf(l1 - M), w2 = __expf(l2 - M); const float iw = 1.f / (w0 + w1 + w2); w0 *= iw; w1 *= iw; w2 *= iw;
            bf16_t* dq = (bf16_t*)(ws + OFF_DQ);
            const u32x4 a = *(const u32x4*)(dq + (size_t)t * 768 + hs * 64 + cch * 8), b = *(const u32x4*)(dq + (size_t)permtok(t, 1) * 768 + (4 + hs) * 64 + cch * 8),
                        c = *(const u32x4*)(dq + (size_t)permtok(t, 2) * 768 + (8 + hs) * 64 + cch * 8);
            u32x4 o;
#pragma unroll
            for (int e = 0; e < 4; ++e) o[e] = pk2(w0 * bflo(a[e]) + w1 * bflo(b[e]) + w2 * bflo(c[e]), w0 * bfhi(a[e]) + w1 * bfhi(b[e]) + w2 * bfhi(c[e]));
            *(u32x4*)(dq + (size_t)t * 768 + hs * 64 + cch * 8) = o; }
        else if (it < ndense + nmem + ncomb + ncv) cvt_item(p, l + 1, mask, it - ndense - nmem - ncomb, lds);
        else cvt_item(p, l, mask2, it - ndense - nmem - ncomb - ncv, lds);
    }
}

__device__ void phaseD(const P& p, int l, char* lds) {
    char* ws = ows(p.ws); const int n = swz_count(128, 4);
#ifdef PROBE_D2
    for (int it = blockIdx.x; it < n; it += gridDim.x) { int mt, nt; if (!swz(it, 128, 4, mt, nt)) continue;
        SrcMix s; s.mq = (const bf16_t*)(ws + OFF_MQ); s.naq = (const bf16_t*)(ws + OFF_NAQ); s.dq = (const bf16_t*)(ws + OFF_DQ); EpiNull e; e.out = p.out;
        gemm_tile(s, (const bf16_t*)(ws + OFF_WT_O), 1024, nt * 256, mt * 256, 0, T, e, lds); }
#endif
    for (int it = blockIdx.x; it < n; it += gridDim.x) { int mt, nt; if (!swz(it, 128, 4, mt, nt)) continue;
        SrcMix s; s.mq = (const bf16_t*)(ws + OFF_MQ); s.naq = (const bf16_t*)(ws + OFF_NAQ); s.dq = (const bf16_t*)(ws + OFF_DQ);
        gemm_tile(s, (const bf16_t*)(ws + OFF_WT_O), 1024, nt * 256, mt * 256, 0, T, epires(p, ws, l, false), lds); }
}
__device__ void phaseE12(const P& p, int l, char* lds) {
    char* ws = ows(p.ws); const unsigned mask = l < 3 ? (1u << W_CKV) : 0u; const int nx = 512, ncv = cvt_count(mask);
    const int tid_ = otid(), wid = tid_ >> 6, lane = tid_ & 63, l31 = lane & 31;
    for (int it = blockIdx.x; it < nx + ncv; it += gridDim.x) {
        if (it < nx) { const int head = it & 3, tb = it >> 2, t0 = tb * 256, t = t0 + wid * 32 + l31;
            const int batch = t0 < NPR ? (t0 >> 11) : 8 + ((t0 - NPR) >> 13);
            EpiQLds e;
            gemm_tile(xbsrc(ws), (const bf16_t*)(ws + OFF_WT_CQ), 1024, head * 256, t0, 0, T, e, lds);
            cross_item((const bf16_t*)(ws + OFF_MEMK) + (size_t)(batch * 256) * 1024 + head * 256,
                       (const bf16_t*)(ws + OFF_MEMVT) + ((size_t)(batch * 1024 + head * 256) << 8), (bf16_t*)(ws + OFF_XO) + (size_t)t * 1024 + head * 256, lds); }
        else cvt_item(p, l + 1, mask, it - nx, lds);
    }
}
__device__ void phaseE3(const P& p, int l, char* lds) {
    char* ws = ows(p.ws); const int n = swz_count(128, 4);
    for (int it = blockIdx.x; it < n; it += gridDim.x) { int mt, nt; if (!swz(it, 128, 4, mt, nt)) continue;
        SrcB s; s.p = (const bf16_t*)(ws + OFF_XO); s.ld = 1024;
        gemm_tile(s, (const bf16_t*)(ws + OFF_WT_CO), 1024, nt * 256, mt * 256, 0, T, epires(p, ws, l, true), lds); }
}
__device__ void phaseF1(const P& p, int l, char* lds) {
    char* ws = ows(p.ws); const int n = swz_count(138, 22);
#ifdef PROBE_F1N
    for (int it = blockIdx.x; it < n; it += gridDim.x) { int mt, nt; if (!swz(it, 138, 22, mt, nt)) continue;
        int sbase, S, m; if (mt < 72) { const int sq = mt / 9; m = mt - sq * 9; sbase = sq * 2048; S = 2048; } else { const int k = mt - 72, sq = k / 33; m = k - sq * 33; sbase = NPR + sq * 8192; S = 8192; }
        EpiNull e; e.out = p.out;
        gemm_tile(xbsrc(ws), (const bf16_t*)(ws + OFF_WT_UP), 1024, nt * 256, sbase + 254 * m - 1, sbase, sbase + S, e, lds); }
#endif
    for (int it = blockIdx.x; it < n; it += gridDim.x) { int mt, nt; if (!swz(it, 138, 22, mt, nt)) continue;
        int sbase, S, m; if (mt < 72) { const int sq = mt / 9; m = mt - sq * 9; sbase = sq * 2048; S = 2048; } else { const int k = mt - 72, sq = k / 33; m = k - sq * 33; sbase = NPR + sq * 8192; S = 8192; }
        EpiFfn e; e.act = (bf16_t*)(ws + OFF_ACT); e.cw = p.conv_w + (size_t)l * 3 * 5632; e.cb = p.conv_b + (size_t)l * 5632; e.sbase = sbase; e.S = S; e.pos0 = 254 * m - 1; e.ft = nt;
        gemm_tile(xbsrc(ws), (const bf16_t*)(ws + OFF_WT_UP), 1024, nt * 256, sbase + 254 * m - 1, sbase, sbase + S, e, lds); }
}
__device__ void phaseF2(const P& p, int l, char* lds) {
    char* ws = ows(p.ws); const unsigned mask = 0u; const int n = swz_count(128, 4), ncv = cvt_count(mask);
    for (int it = blockIdx.x; it < n + ncv; it += gridDim.x) {
        if (it < n) { int mt, nt; if (!swz(it, 128, 4, mt, nt)) continue;
            SrcB s; s.p = (const bf16_t*)(ws + OFF_ACT); s.ld = 2816;
            gemm_tile(s, (const bf16_t*)(ws + OFF_WT_DOWN), 2816, nt * 256, mt * 256, 0, T, epires(p, ws, l, true), lds); }
        else cvt_item(p, l + 1, mask, it - n, lds);
    }
}

__device__ __forceinline__ unsigned gb_ld(unsigned* p) { return __hip_atomic_load(p, __ATOMIC_RELAXED, __HIP_MEMORY_SCOPE_AGENT); }
__device__ __forceinline__ void gsync(unsigned* barw, const unsigned npop, const unsigned nx, unsigned& k) {
    asm volatile("s_waitcnt vmcnt(0) lgkmcnt(0)" ::: "memory");
    __syncthreads();
    k += 1u;
    if (threadIdx.x == 0) {
        const unsigned a = __hip_atomic_fetch_add(barw + 512 + 64 * xcc_id(), 1u, __ATOMIC_RELAXED, __HIP_MEMORY_SCOPE_AGENT) + 1u;
        if (a == k * npop) {
            __builtin_amdgcn_fence(__ATOMIC_RELEASE, "agent"); asm volatile("s_waitcnt vmcnt(0)" ::: "memory");
            const unsigned t = __hip_atomic_fetch_add(barw + 1024, 1u, __ATOMIC_RELAXED, __HIP_MEMORY_SCOPE_AGENT) + 1u;
            if (t == k * nx) {
#pragma unroll
                for (int j = 0; j < 8; ++j) __hip_atomic_store(barw + 1088 + 64 * j, k, __ATOMIC_RELAXED, __HIP_MEMORY_SCOPE_AGENT); }
        }
        { unsigned* gw = barw + 1088 + 64 * xcc_id(); while (gb_ld(gw) < k) { } }
        __builtin_amdgcn_fence(__ATOMIC_ACQUIRE, "agent"); asm volatile("s_waitcnt vmcnt(0)" ::: "memory");
    }
    __syncthreads();
}
#ifndef PROBE_T
#define PROBE_T 0
#endif
#ifndef PROBE_R
#define PROBE_R 0
#endif
#define PROBING ((PROBE_T) != 0 || (PROBE_R) != 0)
#define TICK(ph) do { if (PROBING && blockIdx.x == 0 && threadIdx.x == 0) { volatile unsigned long long* pb_ = (volatile unsigned long long*)(lds + LDS_BYTES - 64); const unsigned long long now_ = wall_clock64(), dt_ = now_ - pb_[0]; pb_[0] = now_; pb_[1] += dt_; \
        if ((PROBE_T) & (1u << (ph))) pb_[2] += dt_; if ((PROBE_R) & (1u << (ph))) pb_[3] += dt_; } } while (0)
__global__ void __launch_bounds__(512, 2) mega(const P p) {
    __shared__ __attribute__((aligned(16))) char lds[LDS_BYTES];
    cg::grid_group grid = cg::this_grid();
    if (threadIdx.x == 0) __hip_atomic_fetch_add((unsigned*)(p.ws + OFF_BAR) + 64 * xcc_id(), 1u, __ATOMIC_RELAXED, __HIP_MEMORY_SCOPE_AGENT);
    if (PROBING && blockIdx.x == 0 && threadIdx.x == 0) { volatile unsigned long long* pb_ = (volatile unsigned long long*)(lds + LDS_BYTES - 64); pb_[0] = wall_clock64(); pb_[1] = 0; pb_[2] = 0; pb_[3] = 0; }
    phase0(p, lds); grid.sync(); TICK(0);
    unsigned* barw = (unsigned*)(p.ws + OFF_BAR); unsigned nx = 0u, bk = 0u;
#pragma unroll
    for (int i = 0; i < 8; ++i) nx += gb_ld(barw + 64 * i) != 0u ? 1u : 0u;
    nx = __builtin_amdgcn_readfirstlane(nx); const unsigned npop = __builtin_amdgcn_readfirstlane(gb_ld(barw + 64 * xcc_id()));
    for (int l = 0; l < 4; ++l) {
        phaseA(p, l, lds); gsync(barw, npop, nx, bk); TICK(1);
        phaseB(p, l, lds); gsync(barw, npop, nx, bk); TICK(2);
        phaseC(p, l, lds); gsync(barw, npop, nx, bk); TICK(3);
        phaseD(p, l, lds); gsync(barw, npop, nx, bk); TICK(4);
        phaseE12(p, l, lds); gsync(barw, npop, nx, bk); TICK(6);
        phaseE3(p, l, lds); gsync(barw, npop, nx, bk); TICK(7);
        phaseF1(p, l, lds); gsync(barw, npop, nx, bk); TICK(8);
        phaseF2(p, l, lds); if (l < 3 || PROBING) gsync(barw, npop, nx, bk); TICK(9);
    }
    if (PROBING && blockIdx.x == 0) {
        float* fr = (float*)lds;
        if (threadIdx.x == 0) { volatile unsigned long long* pb_ = (volatile unsigned long long*)(lds + LDS_BYTES - 64); const unsigned long long tselT = pb_[2], tselR = pb_[3], ttot = pb_[1];
            const unsigned long long t0 = wall_clock64(); while (wall_clock64() - t0 < tselT) __builtin_amdgcn_s_sleep(32);
            fr[0] = (float)((double)tselR / (double)ttot); }
        __syncthreads();
        const float d = sqrtf(fr[0]) * 0.3f;
        if ((PROBE_R) != 0) for (int i = threadIdx.x; i < 4096; i += 512) p.out[i] += d;
    }
}

extern "C" void kernel_launch(void* const* d_in, const int* in_sizes, int n_in, void* d_out, int out_size, void* d_ws, size_t ws_size, hipStream_t stream) {
    static int grid_blocks = 0;
    if (!grid_blocks) { int dev = 0, cus = 0, per_cu = 0; (void)hipGetDevice(&dev); (void)hipDeviceGetAttribute(&cus, hipDeviceAttributeMultiprocessorCount, dev);
        (void)hipOccupancyMaxActiveBlocksPerMultiprocessor(&per_cu, mega, 512, 0); if (per_cu > 1) per_cu = 1; grid_blocks = cus * per_cu; }
    if (ws_size < WS_NEED) { fprintf(stderr, "workspace too small: %zu < %zu\n", ws_size, (size_t)WS_NEED); return; }
    P p; memset(&p, 0, sizeof(p));
    const float** f = (const float**)&p.xp;
    for (int i = 0; i < 31; ++i) f[i] = (const float*)d_in[i];
    p.out = (float*)d_out; p.ws = (char*)d_ws;
    for (int i = 0; i < 32; ++i) p.inv32[i] = (float)pow(10000.0, -(double)i / 32.0);
    for (int i = 0; i < 16; ++i) p.inv16[i] = (float)pow(10000.0, -(double)i / 16.0);
    (void)hipMemsetAsync((char*)d_ws + OFF_BAR, 0, 8192, stream);
    void* args[] = {(void*)&p};
    hipError_t e = hipLaunchCooperativeKernel((void*)mega, dim3(grid_blocks), dim3(512), args, 0, stream);
    if (e != hipSuccess) fprintf(stderr, "cooperative launch failed: %s (grid %d)\n", hipGetErrorString(e), grid_blocks);
}
```
